# Optimizing an MI355X kernel written in HIP

```python
import math
import jax, jax.numpy as jnp
from jax import lax
import numpy as np

D_MODEL = 1024
BATCH = 32
SEQ = 2048
DEPTH = 2

CHUNK = 64
Q_BLOCK = 128
HEAD_DIM = 64
N_HEADS_TOTAL = D_MODEL // HEAD_DIM
N_HEADS_B = N_HEADS_TOTAL // 4
N_HEADS_A = (N_HEADS_TOTAL - N_HEADS_B) // 2
N_HEADS_C = N_HEADS_TOTAL - N_HEADS_A - N_HEADS_B
DIFF_QK_DIM = HEAD_DIM // 2
DIFF_V_DIM = HEAD_DIM
WIDTH_A = N_HEADS_A * HEAD_DIM
WIDTH_B = N_HEADS_B * DIFF_V_DIM
WIDTH_C = N_HEADS_C * HEAD_DIM
B_QK_WIDTH = N_HEADS_B * 2 * DIFF_QK_DIM
D_MIX = WIDTH_A + WIDTH_B + WIDTH_C
IN_COLS = 3 * WIDTH_A + 2 * B_QK_WIDTH + WIDTH_B + 3 * WIDTH_C
LEFT_CHUNKS = 8
BAND = (LEFT_CHUNKS + 1) * CHUNK
REL_CLIP = 128
D_FF = 2816
NORM_EPS = 1e-6
NEG_INF = -1e30
FFN_RESIDUAL_WEIGHT = 0.5

kernel_name = "hybrid_chunk_causal_hymba_encoder"


def rmsnorm(x, g):
    xf = x.astype(jnp.float32)
    y = xf * lax.rsqrt(jnp.mean(xf * xf, axis=-1, keepdims=True) + NORM_EPS)
    return (y * g.astype(jnp.float32)).astype(x.dtype)


def swiglu(x, w_gate, w_up, w_down):
    return (jax.nn.silu(x @ w_gate) * (x @ w_up)) @ w_down


def chunk_band_attention(q, k, v, rel_bias):
    b, s, h, d = q.shape
    nc = s // CHUNK
    qc = q.reshape(b, nc, CHUNK, h, d)
    pad = ((0, 0), (LEFT_CHUNKS, 0), (0, 0), (0, 0), (0, 0))
    kp = jnp.pad(k.reshape(b, nc, CHUNK, h, d), pad)
    vp = jnp.pad(v.reshape(b, nc, CHUNK, h, d), pad)
    kband = jnp.concatenate([kp[:, w:w + nc] for w in range(LEFT_CHUNKS + 1)], axis=2)
    vband = jnp.concatenate([vp[:, w:w + nc] for w in range(LEFT_CHUNKS + 1)], axis=2)
    qi = jnp.arange(CHUNK)
    kk = jnp.arange(BAND)
    rel = jnp.clip(qi[:, None] + LEFT_CHUNKS * CHUNK - kk[None, :], -REL_CLIP, REL_CLIP) + REL_CLIP
    bias = rel_bias[:, rel].astype(jnp.float32)
    valid = (jnp.arange(nc)[:, None] - LEFT_CHUNKS + kk[None, :] // CHUNK) >= 0
    scores = jnp.einsum('bnqhd,bnkhd->bnhqk', qc, kband).astype(jnp.float32) * (d ** -0.5)
    scores = scores + bias[None, None]
    scores = jnp.where(valid[None, :, None, None, :], scores, NEG_INF)
    p = jax.nn.softmax(scores, axis=-1).astype(v.dtype)
    o = jnp.einsum('bnhqk,bnkhd->bnqhd', p, vband)
    return o.reshape(b, s, h, d)


def diff_attention(q, k, v, lam, subln_g, lambda_init):
    b, s, h, _, dq = q.shape
    scale = dq ** -0.5
    slopes = jnp.exp2(-8.0 * jnp.arange(1, h + 1, dtype=jnp.float32) / h)
    outs = []
    for blk in range(s // Q_BLOCK):
        q0 = blk * Q_BLOCK
        kend = q0 + Q_BLOCK
        tpos = q0 + jnp.arange(Q_BLOCK)
        spos = jnp.arange(kend)
        allowed = (spos[None, :] // CHUNK) <= (tpos[:, None] // CHUNK)
        dist = jnp.abs(tpos[:, None] - spos[None, :]).astype(jnp.float32)
        alibi = -slopes[:, None, None] * dist[None]
        sc = jnp.einsum('bqhmd,bkhmd->bhmqk', q[:, q0:kend], k[:, :kend]).astype(jnp.float32) * scale
        sc = sc + alibi[None, :, None]
        sc = jnp.where(allowed[None, None, None], sc, NEG_INF)
        p = jax.nn.softmax(sc, axis=-1)
        w = p[:, :, 0] - lam * p[:, :, 1]
        outs.append(jnp.einsum('bhqk,bkhd->bqhd', w.astype(v.dtype), v[:, :kend]))
    o = jnp.concatenate(outs, axis=1)
    return rmsnorm(o, subln_g) * (1.0 - lambda_init)


def stick_breaking_attention(q, k, v):
    b, s, h, d = q.shape
    scale = d ** -0.5
    outs = []
    for blk in range(s // Q_BLOCK):
        q0 = blk * Q_BLOCK
        kend = q0 + Q_BLOCK
        tpos = q0 + jnp.arange(Q_BLOCK)
        spos = jnp.arange(kend)
        strict = spos[None, :] < tpos[:, None]
        z = jnp.einsum('bqhd,bkhd->bhqk', q[:, q0:kend], k[:, :kend]).astype(jnp.float32) * scale
        log_beta = jax.nn.log_sigmoid(z)
        log_one_minus = jnp.where(strict, jax.nn.log_sigmoid(-z), 0.0)
        suffix = lax.cumsum(log_one_minus, axis=3, reverse=True) - log_one_minus
        a = jnp.where(strict, jnp.exp(log_beta + suffix), 0.0)
        outs.append(jnp.einsum('bhqk,bkhd->bqhd', a.astype(v.dtype), v[:, :kend]))
    return jnp.concatenate(outs, axis=1)


def token_mixing(h, w_in, rel_bias, lq1, lk1, lq2, lk2, subln_g, w_out, lambda_init):
    b, s, _ = h.shape
    proj = h @ w_in
    sizes = [WIDTH_A, WIDTH_A, WIDTH_A, B_QK_WIDTH, B_QK_WIDTH, WIDTH_B, WIDTH_C, WIDTH_C, WIDTH_C]
    qa, ka, va, qb, kb, vb, qc, kc, vc = jnp.split(proj, [int(c) for c in np.cumsum(sizes)[:-1]], axis=-1)
    hd_a = (b, s, N_HEADS_A, HEAD_DIM)
    o_a = chunk_band_attention(qa.reshape(hd_a), ka.reshape(hd_a), va.reshape(hd_a), rel_bias)
    lam = (jnp.exp(jnp.sum(lq1.astype(jnp.float32) * lk1.astype(jnp.float32)))
           - jnp.exp(jnp.sum(lq2.astype(jnp.float32) * lk2.astype(jnp.float32))) + lambda_init)
    hd_bqk = (b, s, N_HEADS_B, 2, DIFF_QK_DIM)
    o_b = diff_attention(qb.reshape(hd_bqk), kb.reshape(hd_bqk), vb.reshape(b, s, N_HEADS_B, DIFF_V_DIM),
                         lam, subln_g, lambda_init)
    hd_c = (b, s, N_HEADS_C, HEAD_DIM)
    o_c = stick_breaking_attention(qc.reshape(hd_c), kc.reshape(hd_c), vc.reshape(hd_c))
    y = jnp.concatenate([o_a.reshape(b, s, WIDTH_A), o_b.reshape(b, s, WIDTH_B),
                         o_c.reshape(b, s, WIDTH_C)], axis=-1)
    return y @ w_out


def setup_inputs(seed: int = 0) -> dict:
    key = jax.random.key(seed)
    ks = jax.random.split(key, 32)
    f32 = jnp.float32

    def nrm(k, shape, scale):
        return jax.random.normal(k, shape, f32) * scale

    def gain(k, shape):
        return 1.0 + 0.05 * jax.random.normal(k, shape, f32)

    L = DEPTH
    return {
        "x": jax.random.normal(ks[0], (BATCH, SEQ, D_MODEL), f32),
        "ffn1_pre_g": gain(ks[1], (L, D_MODEL)),
        "ffn1_w_gate": nrm(ks[2], (L, D_MODEL, D_FF), D_MODEL ** -0.5),
        "ffn1_w_up": nrm(ks[3], (L, D_MODEL, D_FF), D_MODEL ** -0.5),
        "ffn1_w_down": nrm(ks[4], (L, D_FF, D_MODEL), D_FF ** -0.5),
        "ffn1_post_g": gain(ks[5], (L, D_MODEL)),
        "mix_pre_g": gain(ks[6], (L, D_MODEL)),
        "w_in": nrm(ks[7], (L, D_MODEL, IN_COLS), D_MODEL ** -0.5),
        "rel_bias": nrm(ks[8], (L, N_HEADS_A, 2 * REL_CLIP + 1), 0.2),
        "diff_lambda_q1": nrm(ks[9], (L, DIFF_QK_DIM), 0.1),
        "diff_lambda_k1": nrm(ks[10], (L, DIFF_QK_DIM), 0.1),
        "diff_lambda_q2": nrm(ks[11], (L, DIFF_QK_DIM), 0.1),
        "diff_lambda_k2": nrm(ks[12], (L, DIFF_QK_DIM), 0.1),
        "diff_subln_g": gain(ks[13], (L, DIFF_V_DIM)),
        "w_out": nrm(ks[14], (L, D_MIX, D_MODEL), D_MIX ** -0.5),
        "mix_post_g": gain(ks[15], (L, D_MODEL)),
        "ffn2_pre_g": gain(ks[16], (L, D_MODEL)),
        "ffn2_w_gate": nrm(ks[17], (L, D_MODEL, D_FF), D_MODEL ** -0.5),
        "ffn2_w_up": nrm(ks[18], (L, D_MODEL, D_FF), D_MODEL ** -0.5),
        "ffn2_w_down": nrm(ks[19], (L, D_FF, D_MODEL), D_FF ** -0.5),
        "ffn2_post_g": gain(ks[20], (L, D_MODEL)),
    }


def reference(x, ffn1_pre_g, ffn1_w_gate, ffn1_w_up, ffn1_w_down, ffn1_post_g,
              mix_pre_g, w_in, rel_bias, diff_lambda_q1, diff_lambda_k1, diff_lambda_q2,
              diff_lambda_k2, diff_subln_g, w_out, mix_post_g,
              ffn2_pre_g, ffn2_w_gate, ffn2_w_up, ffn2_w_down, ffn2_post_g):
    for l in range(DEPTH):
        lambda_init = 0.8 - 0.6 * math.exp(-0.3 * l)
        f = swiglu(rmsnorm(x, ffn1_pre_g[l]), ffn1_w_gate[l], ffn1_w_up[l], ffn1_w_down[l])
        x = x + FFN_RESIDUAL_WEIGHT * rmsnorm(f, ffn1_post_g[l])
        m = token_mixing(rmsnorm(x, mix_pre_g[l]), w_in[l], rel_bias[l],
                         diff_lambda_q1[l], diff_lambda_k1[l], diff_lambda_q2[l], diff_lambda_k2[l],
                         diff_subln_g[l], w_out[l], lambda_init)
        x = x + rmsnorm(m, mix_post_g[l])
        f = swiglu(rmsnorm(x, ffn2_pre_g[l]), ffn2_w_gate[l], ffn2_w_up[l], ffn2_w_down[l])
        x = x + FFN_RESIDUAL_WEIGHT * rmsnorm(f, ffn2_post_g[l])
    return x
```

```cpp
#include <hip/hip_runtime.h>
#include <hip/hip_cooperative_groups.h>
#include <cstdio>
#include <cstdint>
namespace cg = cooperative_groups;
namespace pg8 {
#define PG8_LAS __attribute__((address_space(3)))
typedef unsigned short bf16_t;
typedef short bf16x8 __attribute__((ext_vector_type(8)));
typedef float f32x4 __attribute__((ext_vector_type(4)));
typedef unsigned u32x4 __attribute__((ext_vector_type(4)));
constexpr int BM = 256, BK = 64, HALF = 128, HTB = HALF * BK * 2  , STAGE_BYTES = 8 * HTB, NXCD = 8, WGM = 8;

__host__ __device__ __forceinline__ int lds_byte(int r, int c) { const int st = (r >> 4) * 2 + (c >> 5), rr = r & 15, cc = c & 31, ob = rr * 64 + cc * 2; return st * 1024 + (ob ^ (((ob >> 9) & 1) << 5)); }
__host__ __device__ __forceinline__ void stage_rc(int b, int& R, int& C) { const int st = b / 1024, sb = b % 1024, swz = sb ^ (((sb >> 9) & 1) << 5); R = (st >> 1) * 16 + swz / 64; C = (st & 1) * 32 + (swz % 64) / 2; }
__host__ __device__ __forceinline__ int perm32(int rho) { const int n = rho >> 4, i = rho & 15; return 8 * (i >> 2) + 4 * n + (i & 3); }

struct Unit { int pm, pn; };
struct Gemm { const bf16_t* A; const bf16_t* Bt; int M, N, K; };

struct StaticOrder {
    int nM, nN, nwg, G, c, rev;
    __host__ __device__ void init(int M, int N, int G_, int c_, int rev_ = 0) { nM = M / BM; nN = N / BM; nwg = nM * nN; G = G_; c = c_; rev = rev_; }
    __host__ __device__ bool next(int i, Unit& u) const {
        const long L = (long)i * G + c; if (L >= nwg) return false;
        int wgid = (int)L; { const int q = nwg / NXCD, r = nwg % NXCD, xcd = wgid % NXCD, off = wgid / NXCD; wgid = (xcd < r ? xcd * (q + 1) : r * (q + 1) + (xcd - r) * q) + off; }
        const int nig = WGM * nN, gid = wgid / nig, fm = gid * WGM, gsz = (nM - fm) < WGM ? (nM - fm) : WGM;
        u.pm = fm + ((wgid % nig) % gsz); u.pn = (wgid % nig) / gsz; if (rev) u.pm = nM - 1 - u.pm; return true;
    }
    __device__ __forceinline__ void a_ready(const Unit&) const {}
    __device__ __forceinline__ void done(const Unit&) const {}
};

__device__ __forceinline__ unsigned cvt_pk_bf16(float lo, float hi) { unsigned r; asm volatile("v_cvt_pk_bf16_f32 %0, %1, %2" : "=v"(r) : "v"(lo), "v"(hi)); return r; }
typedef float f32x2 __attribute__((ext_vector_type(2)));
struct EpiStore {
    static constexpr bool PERM = true, AFTER_DRAIN = false;
    bf16_t* O; int ldc; int qscale; const float* rs;
    __device__ __forceinline__ void operator()(const f32x4 (&acc)[2][2][4][2], const Unit& u, int wr, int wc, int fr, int fq) const {
        const int row0 = u.pm * BM + wr * 64 + fr, col0 = u.pn * BM + wc * 32 + 8 * fq;
        float sc[2] = {1.f, 1.f};
        if (qscale) {
#pragma unroll
            for (int bj = 0; bj < 2; ++bj) { const int hx = 2 * u.pn + bj;
                sc[bj] = (hx <= 2 || (hx >= 15 && hx <= 17)) ? 0.125f * 1.4426950408889634f : ((hx == 9 || hx == 10) ? 0.17677669529663687f * 1.4426950408889634f : 1.f); }
        }
#pragma unroll
        for (int ai = 0; ai < 2; ++ai)
#pragma unroll
            for (int m = 0; m < 4; ++m) { bf16_t* rowp = O + (size_t)(row0 + ai * HALF + m * 16) * ldc + col0; const float rv = rs ? rs[row0 + ai * HALF + m * 16] : 1.f;
#pragma unroll
                for (int bj = 0; bj < 2; ++bj) { const float sb = sc[bj] * rv; const f32x4 v0 = acc[ai][bj][m][0] * sb, v1 = acc[ai][bj][m][1] * sb;
                    u32x4 w; w.x = cvt_pk_bf16(v0[0], v0[1]); w.y = cvt_pk_bf16(v0[2], v0[3]); w.z = cvt_pk_bf16(v1[0], v1[1]); w.w = cvt_pk_bf16(v1[2], v1[3]);
                    __builtin_nontemporal_store(w, (u32x4*)(rowp + bj * HALF)); } }
    }
};
struct EpiSwiGLU {
    static constexpr bool PERM = true, AFTER_DRAIN = false;
    bf16_t* O; int ldc; const float* rs;
    static __device__ __forceinline__ float sw(float g, float u) { return g * u * __builtin_amdgcn_rcpf(1.0f + __builtin_amdgcn_exp2f(-1.4426950408889634f * g)); }
    __device__ __forceinline__ void operator()(const f32x4 (&acc)[2][2][4][2], const Unit& u, int wr, int wc, int fr, int fq) const {
        const int row0 = u.pm * BM + wr * 64 + fr, col0 = u.pn * HALF + wc * 32 + 8 * fq;
#pragma unroll
        for (int ai = 0; ai < 2; ++ai)
#pragma unroll
            for (int m = 0; m < 4; ++m) { bf16_t* rowp = O + (size_t)(row0 + ai * HALF + m * 16) * ldc + col0;
                const float rv = rs[row0 + ai * HALF + m * 16];
                const f32x4 g0 = acc[ai][0][m][0] * rv, g1 = acc[ai][0][m][1] * rv, u0 = acc[ai][1][m][0] * rv, u1 = acc[ai][1][m][1] * rv;
                u32x4 w; w.x = cvt_pk_bf16(sw(g0[0], u0[0]), sw(g0[1], u0[1])); w.y = cvt_pk_bf16(sw(g0[2], u0[2]), sw(g0[3], u0[3]));
                w.z = cvt_pk_bf16(sw(g1[0], u1[0]), sw(g1[1], u1[1])); w.w = cvt_pk_bf16(sw(g1[2], u1[2]), sw(g1[3], u1[3]));
                __builtin_nontemporal_store(w, (u32x4*)rowp); }
    }
};

template <class Epi, class Sched, bool ALIGN_EPI = false, bool SP2 = false>
__device__ __forceinline__ void gemm_phase(PG8_LAS unsigned char* lds, const Gemm g, const Sched& S, const Epi& E, const int tid) {
    const int wid = __builtin_amdgcn_readfirstlane(tid >> 6), lane = tid & 63, wr = wid >> 2, wc = wid & 3, fr = lane & 15, fq = lane >> 4;
    const int K = g.K, nt = K / BK;
    unsigned voffA[2], voffB[2];
#pragma unroll
    for (int i = 0; i < 2; ++i) { int R, C; stage_rc(tid * 16 + i * 8192, R, C); const int Rb = Epi::PERM ? ((R & ~31) + perm32(R & 31)) : R;
        voffA[i] = (unsigned)(R * K + C) * 2u; voffB[i] = (unsigned)(Rb * K + C) * 2u; }
    const size_t kstep = (size_t)(BK * 2);
    const size_t hstep = (size_t)HALF * K * 2;
    const size_t tstep = 2 * hstep;
    const unsigned ldsw = (unsigned)wid * 1024u;
    const int aoff = lds_byte(wr * 64 + fr, fq * 8), boff = lds_byte(wc * 32 + fr, fq * 8);
#define PG8_SA(b, h) (((b) * 2 + (h)) * HTB)
#define PG8_SB(b, h) ((4 + (b) * 2 + (h)) * HTB)
#define PG8_STAGE(bufoff, gbase, voff) do { _Pragma("unroll") for (int _i = 0; _i < 2; ++_i) \
        __builtin_amdgcn_global_load_lds((const unsigned*)((const char*)(gbase) + (voff)[_i]), (PG8_LAS unsigned*)(lds + (bufoff) + ldsw + _i * 8192), 16, 0, 0); } while (0)
#define PG8_LDA(dst, b, h) do { _Pragma("unroll") for (int m = 0; m < 4; ++m) _Pragma("unroll") for (int k = 0; k < 2; ++k) dst[m][k] = *(const PG8_LAS bf16x8*)(lds + PG8_SA(b, h) + aoff + m * 2048 + k * 1024); } while (0)
#define PG8_LDB(dst, b, h) do { _Pragma("unroll") for (int n = 0; n < 2; ++n) _Pragma("unroll") for (int k = 0; k < 2; ++k) dst[n][k] = *(const PG8_LAS bf16x8*)(lds + PG8_SB(b, h) + boff + n * 2048 + k * 1024); } while (0)
#define PG8_MMA(ai, bj, At, Bt) do { __builtin_amdgcn_s_setprio(1); _Pragma("unroll") for (int m = 0; m < 4; ++m) _Pragma("unroll") for (int n = 0; n < 2; ++n) _Pragma("unroll") for (int k = 0; k < 2; ++k) \
        acc[ai][bj][m][n] = __builtin_amdgcn_mfma_f32_16x16x32_bf16(Bt[n][k], At[m][k], acc[ai][bj][m][n], 0, 0, 0); __builtin_amdgcn_s_setprio(0); } while (0)
#define PG8_WAIT_V(n) asm volatile("s_waitcnt vmcnt(" #n ")" ::: "memory")
#define PG8_WAIT_L(n) asm volatile("s_waitcnt lgkmcnt(" #n ")" ::: "memory")
#define PG8_BAR __builtin_amdgcn_s_barrier()
#define PG8_SCHED __builtin_amdgcn_sched_barrier(0)
    Unit cur, nxt; int ui = 0;
    if (!S.next(0, cur)) return;
    f32x4 acc[2][2][4][2];
#pragma unroll
    for (int a = 0; a < 2; ++a)
#pragma unroll
        for (int b = 0; b < 2; ++b)
#pragma unroll
            for (int m = 0; m < 4; ++m)
#pragma unroll
                for (int n = 0; n < 2; ++n) acc[a][b][m][n] = (f32x4){0.f, 0.f, 0.f, 0.f};
    bf16x8 At[4][2], B0[2][2], B1[2][2];
    const char* cA = (const char*)g.A + (size_t)cur.pm * tstep; const char* cB = (const char*)g.Bt + (size_t)cur.pn * tstep;
    S.a_ready(cur);
    if constexpr (SP2) {
        PG8_STAGE(PG8_SB(0, 0), cB, voffB); PG8_STAGE(PG8_SB(0, 1), cB + hstep, voffB); PG8_STAGE(PG8_SA(0, 0), cA, voffA); PG8_STAGE(PG8_SA(0, 1), cA + hstep, voffA);
        if (wr == 1) PG8_BAR;
        PG8_WAIT_V(2); PG8_BAR;
        PG8_STAGE(PG8_SB(1, 0), cB + kstep, voffB); PG8_STAGE(PG8_SA(1, 0), cA + kstep, voffA); PG8_STAGE(PG8_SB(1, 1), cB + hstep + kstep, voffB);
        PG8_WAIT_V(6); PG8_BAR;
    } else {
        PG8_STAGE(PG8_SB(0, 0), cB, voffB); PG8_STAGE(PG8_SA(0, 0), cA, voffA); PG8_STAGE(PG8_SB(0, 1), cB + hstep, voffB); PG8_STAGE(PG8_SA(0, 1), cA + hstep, voffA);
        if (wr == 1) PG8_BAR;
        PG8_WAIT_V(4); PG8_BAR;
        PG8_STAGE(PG8_SB(1, 0), cB + kstep, voffB); PG8_STAGE(PG8_SA(1, 0), cA + kstep, voffA); PG8_STAGE(PG8_SB(1, 1), cB + hstep + kstep, voffB);
        PG8_WAIT_V(6); PG8_BAR;
    }
    for (;;) {
        const bool has_next = S.next(ui + 1, nxt);
        const char* nA = has_next ? (const char*)g.A + (size_t)nxt.pm * tstep : cA; const char* nB = has_next ? (const char*)g.Bt + (size_t)nxt.pn * tstep : cB;
        for (int t = 0; t < nt; t += 2) {
            const bool last = (t == nt - 2);
            const char* a1 = cA + (size_t)(t + 1) * kstep;
            const char* a2 = last ? nA : cA + (size_t)(t + 2) * kstep; const char* b2 = last ? nB : cB + (size_t)(t + 2) * kstep;
            const char* a3 = a2 + kstep; const char* b3 = b2 + kstep;
            if (last && has_next) S.a_ready(nxt);
            if constexpr (SP2) {
            PG8_LDB(B0, 0, 0); PG8_LDB(B1, 0, 1); PG8_SCHED; PG8_LDA(At, 0, 0); PG8_STAGE(PG8_SA(1, 1), a1 + hstep, voffA);
            PG8_WAIT_V(8); PG8_WAIT_L(0); PG8_BAR; PG8_MMA(0, 0, At, B0); PG8_MMA(0, 1, At, B1); PG8_BAR; PG8_SCHED;
            PG8_LDA(At, 0, 1); PG8_STAGE(PG8_SB(0, 0), b2, voffB); PG8_STAGE(PG8_SB(0, 1), b2 + hstep, voffB); PG8_STAGE(PG8_SA(0, 0), a2, voffA);
            PG8_WAIT_V(8); PG8_WAIT_L(0); PG8_BAR; PG8_MMA(1, 0, At, B0); PG8_MMA(1, 1, At, B1); PG8_BAR; PG8_SCHED;
            PG8_LDB(B0, 1, 0); PG8_LDB(B1, 1, 1); PG8_SCHED; PG8_LDA(At, 1, 0); PG8_STAGE(PG8_SA(0, 1), a2 + hstep, voffA);
            PG8_WAIT_V(8); PG8_WAIT_L(0); PG8_BAR; PG8_MMA(0, 0, At, B0); PG8_MMA(0, 1, At, B1); PG8_BAR; PG8_SCHED;
            PG8_LDA(At, 1, 1); PG8_STAGE(PG8_SB(1, 0), b3, voffB); PG8_STAGE(PG8_SB(1, 1), b3 + hstep, voffB); PG8_STAGE(PG8_SA(1, 0), a3, voffA);
            PG8_WAIT_V(8); PG8_WAIT_L(0); PG8_BAR; PG8_MMA(1, 0, At, B0); PG8_MMA(1, 1, At, B1); PG8_BAR; PG8_SCHED;
            } else {
            PG8_LDB(B0, 0, 0); PG8_SCHED; PG8_LDA(At, 0, 0); PG8_STAGE(PG8_SA(1, 1), a1 + hstep, voffA);
            PG8_WAIT_L(8); PG8_BAR; PG8_WAIT_L(0); PG8_MMA(0, 0, At, B0); PG8_BAR; PG8_SCHED;
            PG8_LDB(B1, 0, 1); PG8_STAGE(PG8_SB(0, 0), b2, voffB);
            PG8_BAR; PG8_WAIT_L(0); PG8_MMA(0, 1, At, B1); PG8_BAR;
            PG8_LDA(At, 0, 1); PG8_STAGE(PG8_SA(0, 0), a2, voffA);
            PG8_BAR; PG8_WAIT_L(0); PG8_MMA(1, 0, At, B0); PG8_BAR; PG8_SCHED;
            PG8_STAGE(PG8_SB(0, 1), b2 + hstep, voffB);
            PG8_WAIT_V(6); PG8_BAR; PG8_MMA(1, 1, At, B1); PG8_BAR;
            PG8_LDB(B0, 1, 0); PG8_SCHED; PG8_LDA(At, 1, 0); PG8_STAGE(PG8_SA(0, 1), a2 + hstep, voffA);
            PG8_WAIT_L(8); PG8_BAR; PG8_WAIT_L(0); PG8_MMA(0, 0, At, B0); PG8_BAR; PG8_SCHED;
            PG8_LDB(B1, 1, 1); PG8_STAGE(PG8_SB(1, 0), b3, voffB);
            PG8_BAR; PG8_WAIT_L(0); PG8_MMA(0, 1, At, B1); PG8_BAR;
            PG8_LDA(At, 1, 1); PG8_STAGE(PG8_SA(1, 0), a3, voffA);
            PG8_BAR; PG8_WAIT_L(0); PG8_MMA(1, 0, At, B0); PG8_BAR; PG8_SCHED;
            PG8_STAGE(PG8_SB(1, 1), b3 + hstep, voffB);
            PG8_WAIT_V(6); PG8_BAR; PG8_MMA(1, 1, At, B1); PG8_BAR;
            }
        }
        if constexpr (ALIGN_EPI) { if (wr == 0) PG8_BAR; }
        if constexpr (!Epi::AFTER_DRAIN) { E(acc, cur, wr, wc, fr, fq); S.done(cur); }
        if (!has_next) break;
#pragma unroll
        for (int a = 0; a < 2; ++a)
#pragma unroll
            for (int b = 0; b < 2; ++b)
#pragma unroll
                for (int m = 0; m < 4; ++m)
#pragma unroll
                    for (int n = 0; n < 2; ++n) acc[a][b][m][n] = (f32x4){0.f, 0.f, 0.f, 0.f};
        cur = nxt; cA = nA; cB = nB; ++ui;
        if constexpr (ALIGN_EPI) { if (wr == 1) PG8_BAR; }
    }
    PG8_WAIT_V(0);
    if constexpr (!ALIGN_EPI) { if (wr == 0) PG8_BAR; }
    PG8_BAR;
    if constexpr (Epi::AFTER_DRAIN) { E.fused(acc, cur, wr, wc, fr, fq, lds, wid, lane); S.done(cur); }
#undef PG8_SA
#undef PG8_SB
#undef PG8_STAGE
#undef PG8_LDA
#undef PG8_LDB
#undef PG8_MMA
#undef PG8_WAIT_V
#undef PG8_WAIT_L
#undef PG8_BAR
#undef PG8_SCHED
}
}

#ifndef MULTI_LAUNCH
#define MULTI_LAUNCH 0
#endif
constexpr int BATCH = 32, SEQ = 2048, DM = 1024, MTOK = BATCH * SEQ, DFF = 2816, NIN = 3072, DEPTH = 2, NGU = 2 * DFF;
constexpr float NORM_EPS = 1e-6f;
constexpr float LOG2E = 1.4426950408889634f;
constexpr int NPH = 1 + 10 * DEPTH;
constexpr int NTHREADS = 512, NWAVES = 8;
constexpr size_t MiB = 1u << 20;
constexpr size_t WS_CTL = 0;
constexpr size_t WS_W = 1 * MiB;
constexpr size_t WL_GU1 = 0, WL_D1 = 11 * MiB, WL_IN = WL_D1 + 11 * MiB / 2, WL_OUT = WL_IN + 6 * MiB, WL_GU2 = WL_OUT + 2 * MiB, WL_D2 = WL_GU2 + 11 * MiB, WL_SIZE = WL_D2 + 11 * MiB / 2;
static_assert(WL_SIZE == 41 * MiB, "weights per layer");
constexpr size_t WS_XN = 84 * MiB, WS_F = 212 * MiB, WS_Y = 340 * MiB, WS_H = 468 * MiB, WS_XB = 852 * MiB, WS_END = 980 * MiB;
static_assert(WS_W + DEPTH * WL_SIZE <= WS_XN, "ws map");
constexpr int RING_BYTES = 131072, LDS_BYTES = 147456, MISC_OFF = RING_BYTES;

#define LAS __attribute__((address_space(3)))
typedef unsigned short bf16_t;
typedef unsigned v4u __attribute__((ext_vector_type(4)));
typedef unsigned v2u __attribute__((ext_vector_type(2)));
typedef float f32x4 __attribute__((ext_vector_type(4)));
typedef float f32x2_t __attribute__((ext_vector_type(2)));
typedef __bf16 bf16x2_t __attribute__((ext_vector_type(2)));
typedef short bf16x8 __attribute__((ext_vector_type(8)));
typedef short s16x4 __attribute__((ext_vector_type(4)));
typedef float f32x16 __attribute__((ext_vector_type(16)));
#define LDS_WAIT() asm volatile("s_waitcnt lgkmcnt(0)" ::: "memory")

__device__ __forceinline__ unsigned pk2(float lo, float hi) { f32x2_t v = {lo, hi}; bf16x2_t b = __builtin_convertvector(v, bf16x2_t); return __builtin_bit_cast(unsigned, b); }
__device__ __forceinline__ float bf_lo(unsigned w) { return __uint_as_float(w << 16); }
__device__ __forceinline__ float bf_hi(unsigned w) { return __uint_as_float(w & 0xffff0000u); }
__device__ __forceinline__ float shx(float v, int lane, int o) { return __int_as_float(__builtin_amdgcn_ds_bpermute((lane ^ o) << 2, __float_as_int(v))); }
__device__ __forceinline__ float wave_sum(float v, int lane) {
#pragma unroll
    for (int o = 1; o < 64; o <<= 1) v += shx(v, lane, o);
    return v;
}

__device__ __forceinline__ void p0_transpose_item(const float* W, int K, int N, bf16_t* WT, int gu, LAS float* scr, int item, int lane, const float* gk) {
    const int nblk = N / 32, kb = item / nblk, nb = item % nblk, k0 = 64 * kb, n0 = 32 * nb;
#pragma unroll 8
    for (int i = 0; i < 32; ++i) { const int kk = 2 * i + (lane >> 5); const float gv = gk ? gk[k0 + kk] : 1.f; scr[kk * 33 + (lane & 31)] = W[(size_t)(k0 + kk) * N + n0 + (lane & 31)] * gv; }
    LDS_WAIT(); asm volatile("" ::: "memory");
    const int c = lane & 7;
    const int r0 = gu ? (256 * (n0 >> 7) + (n0 & 127) + (gu == 2 ? 128 : 0)) : n0;
#pragma unroll
    for (int j = 0; j < 4; ++j) { const int n = (lane >> 3) + 8 * j; const LAS float* s = scr + (8 * c) * 33 + n;
        v4u o; o.x = pk2(s[0 * 33], s[1 * 33]); o.y = pk2(s[2 * 33], s[3 * 33]); o.z = pk2(s[4 * 33], s[5 * 33]); o.w = pk2(s[6 * 33], s[7 * 33]);
        *(v4u*)(WT + (size_t)(r0 + n) * K + k0 + 8 * c) = o; }
    LDS_WAIT(); asm volatile("" ::: "memory");
}

__device__ __forceinline__ float dpp_x(float v, const int ctrl) { return v; }
#define DPP_ADD(v, ctrl) (v) += __int_as_float(__builtin_amdgcn_update_dpp(0, __float_as_int(v), (ctrl), 0xf, 0xf, true))
__device__ __forceinline__ float wave_sum_fast(float v) {
    DPP_ADD(v, 0xB1);
    DPP_ADD(v, 0x4E);
    DPP_ADD(v, 0x141);
    DPP_ADD(v, 0x140);
    v += __int_as_float(__builtin_amdgcn_ds_swizzle(__float_as_int(v), 0x401F));
    auto rr = __builtin_amdgcn_permlane32_swap(__float_as_uint(v), __float_as_uint(v), false, false);
    return __uint_as_float(rr[0]) + __uint_as_float(rr[1]);
}
template <bool HAS_F, bool XS16>
struct RawRows { static constexpr int NR = XS16 ? 4 : 2;
    f32x4 xf[XS16 ? 1 : NR][XS16 ? 1 : 4]; v2u xh[XS16 ? NR : 1][XS16 ? 4 : 1]; v2u fh[HAS_F ? NR : 1][HAS_F ? 4 : 1]; };
template <bool HAS_F, bool XS16>
__device__ __forceinline__ void norm_load(RawRows<HAS_F, XS16>& R, const void* xsrc_, const bf16_t* F, int row, int lane) {
    constexpr int NR = RawRows<HAS_F, XS16>::NR;
#pragma unroll
    for (int q = 0; q < NR; ++q) {
        if (XS16) { const v2u* xr = (const v2u*)((const bf16_t*)xsrc_ + (size_t)(row + q) * DM) + lane;
#pragma unroll
            for (int j = 0; j < 4; ++j) R.xh[XS16 ? q : 0][XS16 ? j : 0] = xr[64 * j]; }
        else { const f32x4* xr = (const f32x4*)((const float*)xsrc_ + (size_t)(row + q) * DM) + lane;
#pragma unroll
            for (int j = 0; j < 4; ++j) R.xf[XS16 ? 0 : q][XS16 ? 0 : j] = xr[64 * j]; }
        if (HAS_F) { const v2u* fp = (const v2u*)(F + (size_t)(row + q) * DM) + lane;
#pragma unroll
            for (int j = 0; j < 4; ++j) R.fh[HAS_F ? q : 0][HAS_F ? j : 0] = fp[64 * j]; }
    }
}
template <bool HAS_F, bool XS16, bool XD16>
__device__ __forceinline__ void norm_rows(const void* xsrc_, const bf16_t* F, float w, const float* gpost, void* xdst_, float* RS, int gw, int ngw, int lane, int rev) {
    constexpr int NR = RawRows<HAS_F, XS16>::NR;
    f32x4 gp[4];
#pragma unroll
    for (int j = 0; j < 4; ++j) gp[j] = HAS_F ? *((const f32x4*)gpost + lane + 64 * j) : (f32x4){0.f, 0.f, 0.f, 0.f};
    const int step = NR * ngw;
    RawRows<HAS_F, XS16> cur;
#define ROWMAP(r_) (rev ? (MTOK - NR - (r_)) : (r_))
    norm_load<HAS_F, XS16>(cur, xsrc_, F, ROWMAP(NR * gw), lane);
    for (int row_ = NR * gw; row_ < MTOK; row_ += step) {
        RawRows<HAS_F, XS16> nxt; const bool hn = row_ + step < MTOK; const int row = ROWMAP(row_);
        if (hn) norm_load<HAS_F, XS16>(nxt, xsrc_, F, ROWMAP(row_ + step), lane);
        f32x4 v[NR][4];
#pragma unroll
        for (int q = 0; q < NR; ++q)
#pragma unroll
            for (int j = 0; j < 4; ++j) { if (XS16) { const v2u t = cur.xh[XS16 ? q : 0][XS16 ? j : 0]; v[q][j] = (f32x4){bf_lo(t.x), bf_hi(t.x), bf_lo(t.y), bf_hi(t.y)}; } else v[q][j] = cur.xf[XS16 ? 0 : q][XS16 ? 0 : j]; }
        if (HAS_F) {
            float ss[NR];
#pragma unroll
            for (int q = 0; q < NR; ++q) { ss[q] = 0.f;
#pragma unroll
                for (int j = 0; j < 4; ++j) { const v2u t = cur.fh[HAS_F ? q : 0][HAS_F ? j : 0]; const f32x4 f = (f32x4){bf_lo(t.x), bf_hi(t.x), bf_lo(t.y), bf_hi(t.y)}; ss[q] += (f.x * f.x + f.y * f.y) + (f.z * f.z + f.w * f.w); } }
#pragma unroll
            for (int q = 0; q < NR; ++q) ss[q] = wave_sum_fast(ss[q]);
#pragma unroll
            for (int q = 0; q < NR; ++q) { const float rs = w * __builtin_amdgcn_rsqf(ss[q] * (1.f / DM) + NORM_EPS);
#pragma unroll
                for (int j = 0; j < 4; ++j) { const v2u t = cur.fh[HAS_F ? q : 0][HAS_F ? j : 0]; const f32x4 f = (f32x4){bf_lo(t.x), bf_hi(t.x), bf_lo(t.y), bf_hi(t.y)}; v[q][j] = v[q][j] + (f * rs) * gp[j]; } }
        }
        if (XD16) {
#pragma unroll
            for (int q = 0; q < NR; ++q) { v2u* xo = (v2u*)((bf16_t*)xdst_ + (size_t)(row + q) * DM) + lane;
#pragma unroll
                for (int j = 0; j < 4; ++j) { v2u t; t.x = pk2(v[q][j].x, v[q][j].y); t.y = pk2(v[q][j].z, v[q][j].w); xo[64 * j] = t;
                    v[q][j] = (f32x4){bf_lo(t.x), bf_hi(t.x), bf_lo(t.y), bf_hi(t.y)}; } }
        } else {
#pragma unroll
            for (int q = 0; q < NR; ++q) { f32x4* xo = (f32x4*)((float*)xdst_ + (size_t)(row + q) * DM) + lane;
#pragma unroll
                for (int j = 0; j < 4; ++j) xo[64 * j] = v[q][j]; }
        }
        if (RS) {
            float s2[NR];
#pragma unroll
            for (int q = 0; q < NR; ++q) { s2[q] = 0.f;
#pragma unroll
                for (int j = 0; j < 4; ++j) s2[q] += (v[q][j].x * v[q][j].x + v[q][j].y * v[q][j].y) + (v[q][j].z * v[q][j].z + v[q][j].w * v[q][j].w); }
#pragma unroll
            for (int q = 0; q < NR; ++q) s2[q] = wave_sum_fast(s2[q]);
            float mine = s2[0];
#pragma unroll
            for (int q = 1; q < NR; ++q) mine = (lane == q) ? s2[q] : mine;
            if (lane < NR) RS[row + lane] = __builtin_amdgcn_rsqf(mine * (1.f / DM) + NORM_EPS);
        }
        if (hn) cur = nxt;
    }
#undef ROWMAP
}

namespace att {
constexpr int KROW = 144, TILEB = 64 * KROW;
constexpr int OFF_K = 0, OFF_V = 2 * TILEB, OFF_BIAS = 4 * TILEB, OFF_UNIT = OFF_BIAS + 1040;
#define MFMA32(a, b, c) __builtin_amdgcn_mfma_f32_32x32x16_bf16((a), (b), (c), 0, 0, 0)
typedef short v4i16_t __attribute__((ext_vector_type(4)));
__device__ __forceinline__ s16x4 vtr(LAS const unsigned char* p) { return __builtin_bit_cast(s16x4, __builtin_amdgcn_ds_read_tr16_b64_v4i16((LAS v4i16_t*)p)); }
__device__ __forceinline__ void xswap(float v, float& v0, float& v1) { auto rr = __builtin_amdgcn_permlane32_swap(__float_as_uint(v), __float_as_uint(v), false, false); v0 = __uint_as_float(rr[0]); v1 = __uint_as_float(rr[1]); }
__device__ __forceinline__ float xmax(float v) { float a, b; xswap(v, a, b); return fmaxf(a, b); }
__device__ __forceinline__ float xsum(float v) { float a, b; xswap(v, a, b); return a + b; }
__device__ __forceinline__ bf16x8 packp(const f32x16& p, int s) {
    v4u w; w.x = pk2(p[8 * s], p[8 * s + 1]); w.y = pk2(p[8 * s + 2], p[8 * s + 3]); w.z = pk2(p[8 * s + 4], p[8 * s + 5]); w.w = pk2(p[8 * s + 6], p[8 * s + 7]);
    return __builtin_bit_cast(bf16x8, w);
}
template <int D0, int D1>
__device__ __forceinline__ f32x16 qk(LAS const unsigned char* kt, int sub, const bf16x8* qf, int r, int h) {
    f32x16 acc = {};
    LAS const unsigned char* kp = kt + (32 * sub + r) * KROW + 16 * h;
#pragma unroll
    for (int d0 = D0; d0 < D1; ++d0) { const bf16x8 kf = *(LAS const bf16x8*)(kp + 32 * d0); acc = MFMA32(kf, qf[d0], acc); }
    return acc;
}
__device__ __forceinline__ void pv(f32x16 (&O)[2], LAS const unsigned char* vt, int sub, const f32x16& p, int lane) {
    const int h = lane >> 5, i16 = lane & 15, q = i16 >> 2, pp = i16 & 3, blk = (lane >> 4) & 1;
    LAS const unsigned char* vp = vt + (32 * sub + 4 * h + q) * KROW + 32 * blk + 8 * pp;
#pragma unroll
    for (int s = 0; s < 2; ++s) {
        const bf16x8 pf = packp(p, s);
#pragma unroll
        for (int dblk = 0; dblk < 2; ++dblk) {
            const s16x4 lo = vtr(vp + (16 * s) * KROW + 64 * dblk), hi = vtr(vp + (16 * s + 8) * KROW + 64 * dblk);
            const bf16x8 vf = __builtin_shufflevector(lo, hi, 0, 1, 2, 3, 4, 5, 6, 7);
            O[dblk] = MFMA32(vf, pf, O[dblk]);
        }
    }
}
__device__ __forceinline__ void osm(f32x16& p0, f32x16& p1, float lbase, float& m, float& l, f32x16 (&O)[2]) {
#define MX2(a, b) __builtin_amdgcn_fmed3f((a), (b), 3.0e38f)
    float ra = MX2(p0[0], p1[0]), rb = MX2(p0[1], p1[1]);
#pragma unroll
    for (int i = 2; i < 16; i += 2) { ra = MX2(ra, MX2(p0[i], p1[i])); rb = MX2(rb, MX2(p0[i + 1], p1[i + 1])); }
    float rm = MX2(ra, rb);
#undef MX2
    rm = xmax(rm + lbase);
    if (__any(rm > m + 8.0f)) {
        const float mn = fmaxf(m, rm), alpha = __builtin_amdgcn_exp2f(m - mn); m = mn; l *= alpha;
#pragma unroll
        for (int i = 0; i < 16; ++i) { O[0][i] *= alpha; O[1][i] *= alpha; }
    }
    const float mm = m - lbase; float s = 0.f;
#pragma unroll
    for (int i = 0; i < 16; ++i) { p0[i] = __builtin_amdgcn_exp2f(p0[i] - mm); p1[i] = __builtin_amdgcn_exp2f(p1[i] - mm); s += p0[i] + p1[i]; }
    l += s;
}

template <int MODE>
__device__ __forceinline__ void attn_unit(LAS unsigned char* lds, const bf16_t* PROJ, bf16_t* Y, int b, int qb, int colQ, int colK, int colV, int colO,
                                          const float* relb, float slope2, float lam, const float* subg, float outscale, const int tid) {
    const int lane = tid & 63, r = lane & 31, h = lane >> 5; const int w = __builtin_amdgcn_readfirstlane(tid >> 6);
    const int tq0 = qb * 256 + 32 * w, t = tq0 + r;
    const size_t rowb = (size_t)b * SEQ;
    LAS unsigned char* Kb = lds + OFF_K; LAS unsigned char* Vb = lds + OFF_V; LAS float* biasl = (LAS float*)(lds + OFF_BIAS);
    const int c0 = 4 * qb;
    const int kt_lo = (MODE == 0) ? (c0 - 8 > 0 ? c0 - 8 : 0) : 0, kt_hi = c0 + 3, nt = kt_hi - kt_lo + 1;
    const int cw = c0 + (w >> 1);
    const int lrow = tid >> 3, lch = tid & 7;
    const bf16_t* kg = PROJ + (rowb + lrow) * NIN + colK + lch * 8;
    const bf16_t* vg = PROJ + (rowb + lrow) * NIN + colV + lch * 8;
    const int lofs = lrow * KROW + lch * 16;
#define KT(i) ((MODE == 2) ? (kt_hi - (i)) : (kt_lo + (i)))
    v4u kr = *(const v4u*)(kg + (size_t)KT(0) * 64 * NIN), vr = *(const v4u*)(vg + (size_t)KT(0) * 64 * NIN);
    if (MODE == 0) { if (tid < 257) biasl[tid] = relb[tid] * LOG2E; }
    bf16x8 qf[4];
    { const bf16_t* qp = PROJ + (rowb + t) * NIN + colQ + 8 * h;
#pragma unroll
      for (int d0 = 0; d0 < 4; ++d0) qf[d0] = *(const bf16x8*)(qp + 16 * d0); }
    *(LAS v4u*)(Kb + lofs) = kr; *(LAS v4u*)(Vb + lofs) = vr;
    __syncthreads();
    f32x16 O0[2] = {}, O1[2] = {};
    float m0 = -1e30f, l0 = 0.f, m1 = -1e30f, l1 = 0.f, Prun = 1.f;
    if (MODE == 1) asm volatile("" : "+v"(slope2));
    for (int i = 0; i < nt; ++i) {
        const int kt = KT(i), buf = i & 1;
        if (i + 1 < nt) { kr = *(const v4u*)(kg + (size_t)KT(i + 1) * 64 * NIN); vr = *(const v4u*)(vg + (size_t)KT(i + 1) * 64 * NIN); }
        LAS const unsigned char* ktile = Kb + buf * TILEB; LAS const unsigned char* vtile = Vb + buf * TILEB;
        int wdone = 0;
        if (MODE == 0) {
            if (kt >= cw - 8 && kt <= cw) {
                f32x16 p0 = qk<0, 4>(ktile, 0, qf, r, h), p1 = qk<0, 4>(ktile, 1, qf, r, h);
                float lb = 0.f;
                if (kt <= cw - 3) lb = biasl[256];
                else { const int d0 = t - (kt * 64 + 4 * h) + 128;
#pragma unroll
                    for (int j = 0; j < 16; ++j) { const int ko = (j & 3) + 8 * (j >> 2); int i0 = d0 - ko, i1 = d0 - ko - 32;
                        i0 = i0 < 0 ? 0 : (i0 > 256 ? 256 : i0); i1 = i1 < 0 ? 0 : (i1 > 256 ? 256 : i1);
                        p0[j] += biasl[i0]; p1[j] += biasl[i1]; }
                }
                osm(p0, p1, lb, m0, l0, O0);
                pv(O0, vtile, 0, p0, lane); pv(O0, vtile, 1, p1, lane);
            }
        } else if (MODE == 1) {
            if (kt <= cw) {
                const float dist0 = (float)(t - (kt * 64 + 4 * h));
                const bool diag = (kt == cw);
                const float lb = diag ? 0.f : -slope2 * dist0;
                { f32x16 p0 = qk<0, 2>(ktile, 0, qf, r, h), p1 = qk<0, 2>(ktile, 1, qf, r, h);
                  if (diag) {
#pragma unroll
                      for (int j = 0; j < 16; ++j) { const float ko = (float)((j & 3) + 8 * (j >> 2)); p0[j] -= slope2 * fabsf(dist0 - ko); p1[j] -= slope2 * fabsf(dist0 - ko - 32.f); }
                  } else {
#pragma unroll
                      for (int j = 0; j < 16; ++j) { const float ko = (float)((j & 3) + 8 * (j >> 2)); p0[j] = fmaf(slope2, ko, p0[j]); p1[j] = fmaf(slope2, ko + 32.f, p1[j]); }
                  }
                  osm(p0, p1, lb, m0, l0, O0); pv(O0, vtile, 0, p0, lane); pv(O0, vtile, 1, p1, lane); }
                { float dist1 = dist0; int vo = buf * TILEB; asm volatile("" : "+v"(dist1), "+s"(vo));
                  LAS const unsigned char* vtile1 = Vb + vo;
                  f32x16 p0 = qk<2, 4>(ktile, 0, qf, r, h), p1 = qk<2, 4>(ktile, 1, qf, r, h);
                  if (diag) {
#pragma unroll
                      for (int j = 0; j < 16; ++j) { const float ko = (float)((j & 3) + 8 * (j >> 2)); p0[j] -= slope2 * fabsf(dist1 - ko); p1[j] -= slope2 * fabsf(dist1 - ko - 32.f); }
                  } else {
#pragma unroll
                      for (int j = 0; j < 16; ++j) { const float ko = (float)((j & 3) + 8 * (j >> 2)); p0[j] = fmaf(slope2, ko, p0[j]); p1[j] = fmaf(slope2, ko + 32.f, p1[j]); }
                  }
                  osm(p0, p1, lb, m1, l1, O1); pv(O1, vtile1, 0, p0, lane); pv(O1, vtile1, 1, p1, lane); }
            }
        } else {
            if (!__all(Prun < 1e-30f)) {
#pragma unroll
                for (int sub = 1; sub >= 0; --sub) {
                    const int ks = kt * 64 + 32 * sub;
                    if (ks <= tq0) {
                        const int thr = (ks == tq0) ? r - 4 * h : 1000;
                        f32x16 a = qk<0, 4>(ktile, sub, qf, r, h); f32x16 om;
#pragma unroll
                        for (int j = 0; j < 16; ++j) { const bool valid = ((j & 3) + 8 * (j >> 2)) < thr;
                            const float z2 = a[j], e = __builtin_amdgcn_exp2f(-fabsf(z2)), rr = __builtin_amdgcn_rcpf(1.0f + e), er = e * rr; const bool pos = z2 > 0.f;
                            om[j] = valid ? (pos ? er : rr) : 1.f; a[j] = valid ? (pos ? rr : er) : 0.f; }
                        float after = 1.f, carry[4];
#pragma unroll
                        for (int g = 3; g >= 0; --g) { const float G = (om[4 * g] * om[4 * g + 1]) * (om[4 * g + 2] * om[4 * g + 3]); float G0, G1; xswap(G, G0, G1);
                            carry[g] = (Prun * after) * (h == 0 ? G1 : 1.f); after *= G0 * G1; }
                        Prun *= after;
#pragma unroll
                        for (int g = 0; g < 4; ++g) { const float s3 = carry[g], s2 = s3 * om[4 * g + 3], s1 = s2 * om[4 * g + 2], s0 = s1 * om[4 * g + 1];
                            a[4 * g + 3] *= s3; a[4 * g + 2] *= s2; a[4 * g + 1] *= s1; a[4 * g] *= s0; }
                        pv(O0, vtile, sub, a, lane);
                    }
                }
            }
            wdone = __all(Prun < 1e-30f);
        }
        if (i + 1 < nt) { const int nb = (i + 1) & 1; *(LAS v4u*)(Kb + nb * TILEB + lofs) = kr; *(LAS v4u*)(Vb + nb * TILEB + lofs) = vr; }
        if (MODE == 2) { if (__syncthreads_and(wdone)) break; }
        else __syncthreads();
    }
#undef KT
    bf16_t* yp = Y + (rowb + t) * DM + colO + 4 * h;
    if (MODE == 0) { const float il = __builtin_amdgcn_rcpf(xsum(l0));
#pragma unroll
        for (int j = 0; j < 16; ++j) { O0[0][j] *= il; O0[1][j] *= il; }
    } else if (MODE == 1) {
        const float i0 = __builtin_amdgcn_rcpf(xsum(l0)), i1 = lam * __builtin_amdgcn_rcpf(xsum(l1)); float ss = 0.f;
#pragma unroll
        for (int j = 0; j < 16; ++j) { O0[0][j] = O0[0][j] * i0 - O1[0][j] * i1; O0[1][j] = O0[1][j] * i0 - O1[1][j] * i1; ss += O0[0][j] * O0[0][j] + O0[1][j] * O0[1][j]; }
        const float rs = __builtin_amdgcn_rsqf(xsum(ss) * (1.f / 64.f) + NORM_EPS) * outscale;
#pragma unroll
        for (int dblk = 0; dblk < 2; ++dblk)
#pragma unroll
            for (int g = 0; g < 4; ++g) { const f32x4 gg = *(const f32x4*)(subg + 32 * dblk + 8 * g + 4 * h);
                O0[dblk][4 * g] *= rs * gg.x; O0[dblk][4 * g + 1] *= rs * gg.y; O0[dblk][4 * g + 2] *= rs * gg.z; O0[dblk][4 * g + 3] *= rs * gg.w; }
    }
#pragma unroll
    for (int dblk = 0; dblk < 2; ++dblk)
#pragma unroll
        for (int g = 0; g < 4; ++g) { v2u o; o.x = pk2(O0[dblk][4 * g], O0[dblk][4 * g + 1]); o.y = pk2(O0[dblk][4 * g + 2], O0[dblk][4 * g + 3]);
            *(v2u*)(yp + 32 * dblk + 8 * g) = o; }
}
}

constexpr int CW_BAR = 4096;
#define XB_TMO      128
#define XB_XCNT(j)  (256  + 64 * (j))
#define XB_XSUB(j)  (1280 + 64 * (j))
#define XB_XGEN(j)  (2304 + 64 * (j))
#define XB_TOP      3328
#define XB_TOPGEN   3392
#define XCD_BAR_WORDS 3456
#define XB_SPIN_CAP (1u << 18)

__device__ __forceinline__ unsigned xb_ld(unsigned* p)              { return __hip_atomic_load(p, __ATOMIC_RELAXED, __HIP_MEMORY_SCOPE_AGENT); }
__device__ __forceinline__ unsigned xb_add(unsigned* p, unsigned v) { return __hip_atomic_fetch_add(p, v, __ATOMIC_RELAXED, __HIP_MEMORY_SCOPE_AGENT); }
__device__ __forceinline__ unsigned xb_xcc_id() { return (unsigned)__builtin_amdgcn_s_getreg((3 << 11) | 20) & 0xFu; }
#define XB_SPIN(cond, bar) do { unsigned _sp = 0; while (cond) { __builtin_amdgcn_s_sleep(1); \
    if ((++_sp & 255u) == 0u) { if (xb_ld(&(bar)[XB_TMO])) break; if (_sp > XB_SPIN_CAP) { atomicAdd(&(bar)[XB_TMO], 1u); break; } } } } while (0)

struct XcdBarrier {
    unsigned* bar; unsigned x;
    volatile LAS unsigned* st;
};

__device__ __forceinline__ XcdBarrier xcd_barrier_post(unsigned* bar, volatile LAS unsigned* st) {
    XcdBarrier b; b.bar = bar; b.x = xb_xcc_id(); b.st = st;
    if (threadIdx.x == 0) (void)xb_add(&bar[XB_XCNT(b.x)], 1u);
    return b;
}
__device__ __forceinline__ void xcd_barrier_complete(unsigned* bar, unsigned x, unsigned& nloc, unsigned& nx) {
    const unsigned G = gridDim.x * gridDim.y * gridDim.z;
    unsigned sum, cnt, mine, sp = 0u;
    for (;;) {
        sum = 0u; cnt = 0u; mine = 0u;
#pragma unroll
        for (unsigned j = 0; j < 16; ++j) { const unsigned c = xb_ld(&bar[XB_XCNT(j)]); sum += c; cnt += (c > 0u) ? 1u : 0u; mine = (j == x) ? c : mine; }
        if (sum == G) break;
        __builtin_amdgcn_s_sleep(1);
        if ((++sp & 255u) == 0u) { if (xb_ld(&bar[XB_TMO])) break; if (sp > XB_SPIN_CAP) { atomicAdd(&bar[XB_TMO], 1u); break; } }
    }
    nloc = mine > 0u ? mine : 1u; nx = cnt > 0u ? cnt : 1u;
}

__device__ __forceinline__ void xcd_barrier(const XcdBarrier& b) {
    asm volatile("s_waitcnt vmcnt(0)" ::: "memory");
    __syncthreads();
    if (threadIdx.x == 0) {
        unsigned* bar = b.bar;
        __builtin_amdgcn_s_waitcnt(0);
        unsigned nloc = b.st[0], nx = b.st[1];
        if (nloc == 0u) { xcd_barrier_complete(bar, b.x, nloc, nx); b.st[0] = nloc; b.st[1] = nx; }
        const unsigned old = xb_add(&bar[XB_XSUB(b.x)], 1u);
        const unsigned gen = old / nloc;
        if (old + 1u == (gen + 1u) * nloc) {
            __builtin_amdgcn_fence(__ATOMIC_RELEASE, "agent");
            asm volatile("s_waitcnt vmcnt(0)" ::: "memory");
            const unsigned og = xb_add(&bar[XB_TOP], 1u);
            const unsigned tg = og / nx;
            if (og + 1u == (tg + 1u) * nx) xb_add(&bar[XB_TOPGEN], 1u);
            else XB_SPIN(xb_ld(&bar[XB_TOPGEN]) == tg, bar);
            __builtin_amdgcn_fence(__ATOMIC_ACQUIRE, "agent");
            xb_add(&bar[XB_XGEN(b.x)], 1u);
            asm volatile("s_waitcnt vmcnt(0)" ::: "memory");
        } else {
            XB_SPIN(xb_ld(&bar[XB_XGEN(b.x)]) == gen, bar);
            __builtin_amdgcn_fence(__ATOMIC_ACQUIRE, "agent");
            asm volatile("s_waitcnt vmcnt(0)" ::: "memory");
        }
    }
    __syncthreads();
}

struct Args { const float* in[21]; float* out; unsigned char* ws; int ph_lo, ph_hi; };
__global__ void __launch_bounds__(NTHREADS, 2) mega_fwd(Args args) {
    extern __shared__ __attribute__((aligned(16))) unsigned char lds_raw[];
    LAS unsigned char* lds = (LAS unsigned char*)lds_raw;
    const int lo = args.ph_lo, hi = args.ph_hi;
    { LAS unsigned* misc0 = (LAS unsigned*)(lds + MISC_OFF); if (threadIdx.x < 64) misc0[threadIdx.x] = 0u; __syncthreads(); }
#ifdef PROBE_REP
    const int hi_x = hi + 1;
#else
    const int hi_x = hi;
#endif
    for (int phx = lo; phx < hi_x; ++phx) {
#ifdef PROBE_REP
        const int ph = phx <= PROBE_REP ? phx : phx - 1; const int rep = (phx == PROBE_REP + 1) ? 1 : 0;
#else
        const int ph = phx; const int rep = 0;
#endif
        int tid = threadIdx.x; asm volatile("" : "+v"(tid));
        typedef const __attribute__((address_space(4))) Args* cargs_t;
        cargs_t ap = (cargs_t)__builtin_amdgcn_kernarg_segment_ptr(); asm volatile("" : "+s"(ap));
#define args (*ap)
        const int lane = tid & 63; const int wave = __builtin_amdgcn_readfirstlane(tid >> 6);
        int bid = blockIdx.x, G = gridDim.x; asm volatile("" : "+s"(bid), "+s"(G));
        const int gw = bid * NWAVES + wave, ngw = G * NWAVES;
        unsigned char* ws = args.ws;
        unsigned* ctl = (unsigned*)(ws + WS_CTL);
        float* RS = (float*)(ws + WS_XN); bf16_t* FB = (bf16_t*)(ws + WS_F); bf16_t* YB = (bf16_t*)(ws + WS_Y); bf16_t* HB = (bf16_t*)(ws + WS_H); bf16_t* PROJ = HB; bf16_t* XB = (bf16_t*)(ws + WS_XB);
#ifdef PROBE_EMPTY
        if (rep) {   } else
#endif
        if (ph == 0) {
            if (bid == 0) { if (tid < 4 * 2 * DEPTH) ctl[64 * tid] = 0u; for (int i = tid; i < XCD_BAR_WORDS; i += NTHREADS) ctl[CW_BAR + i] = 0u; }
            LAS float* scr = (LAS float*)(lds + wave * 16384);
            constexpr int I_GU = (DM / 64) * (DFF / 32), I_D = (DFF / 64) * (DM / 32), I_IN = (DM / 64) * (NIN / 32), I_OUT = (DM / 64) * (DM / 32);
            constexpr int I_LAYER = 4 * I_GU + 2 * I_D + I_IN + I_OUT;
            for (int it = gw; it < DEPTH * I_LAYER; it += ngw) {
                const int l = it / I_LAYER; int rr = it % I_LAYER;
                unsigned char* wl = ws + WS_W + (size_t)l * WL_SIZE;
                const size_t ogu = (size_t)l * DM * DFF, oin = (size_t)l * DM * NIN, oout = (size_t)l * DM * DM;
                if (rr < I_GU) { p0_transpose_item(args.in[2] + ogu, DM, DFF, (bf16_t*)(wl + WL_GU1), 1, scr, rr, lane, args.in[1] + DM * l); continue; } rr -= I_GU;
                if (rr < I_GU) { p0_transpose_item(args.in[3] + ogu, DM, DFF, (bf16_t*)(wl + WL_GU1), 2, scr, rr, lane, args.in[1] + DM * l); continue; } rr -= I_GU;
                if (rr < I_D) { p0_transpose_item(args.in[4] + ogu, DFF, DM, (bf16_t*)(wl + WL_D1), 0, scr, rr, lane, nullptr); continue; } rr -= I_D;
                if (rr < I_IN) { p0_transpose_item(args.in[7] + oin, DM, NIN, (bf16_t*)(wl + WL_IN), 0, scr, rr, lane, args.in[6] + DM * l); continue; } rr -= I_IN;
                if (rr < I_OUT) { p0_transpose_item(args.in[14] + oout, DM, DM, (bf16_t*)(wl + WL_OUT), 0, scr, rr, lane, nullptr); continue; } rr -= I_OUT;
                if (rr < I_GU) { p0_transpose_item(args.in[17] + ogu, DM, DFF, (bf16_t*)(wl + WL_GU2), 1, scr, rr, lane, args.in[16] + DM * l); continue; } rr -= I_GU;
                if (rr < I_GU) { p0_transpose_item(args.in[18] + ogu, DM, DFF, (bf16_t*)(wl + WL_GU2), 2, scr, rr, lane, args.in[16] + DM * l); continue; } rr -= I_GU;
                p0_transpose_item(args.in[19] + ogu, DFF, DM, (bf16_t*)(wl + WL_D2), 0, scr, rr, lane, nullptr);
            }
            norm_rows<false, false, true>(args.in[0], nullptr, 0.f, nullptr, XB, RS, gw, ngw, lane, 0);
            __syncthreads();
        } else {
            const int l = (ph - 1) / 10, s = (ph - 1) % 10;
            unsigned char* wl = ws + WS_W + (size_t)l * WL_SIZE;
            if (s == 0 || s == 7) {
                pg8::Gemm g{XB, (const bf16_t*)(wl + (s == 0 ? WL_GU1 : WL_GU2)), MTOK, NGU, DM};
                pg8::StaticOrder S; S.init(MTOK, NGU, G, bid, ph & 1);
                pg8::EpiSwiGLU E{HB, DFF, RS};
                pg8::gemm_phase<pg8::EpiSwiGLU, pg8::StaticOrder, true, true>(lds, g, S, E, tid);
            } else if (s == 1 || s == 3 || s == 5 || s == 8) {
                const bf16_t* A = (s == 1 || s == 8) ? HB : (s == 3 ? XB : YB);
                const size_t wo = (s == 1) ? WL_D1 : (s == 8) ? WL_D2 : (s == 3) ? WL_IN : WL_OUT;
                const int N = (s == 3) ? NIN : DM, K = (s == 1 || s == 8) ? DFF : DM;
                bf16_t* O = (s == 3) ? PROJ : FB;
                pg8::Gemm g{A, (const bf16_t*)(wl + wo), MTOK, N, K};
                pg8::StaticOrder S; S.init(MTOK, N, G, bid, ph & 1);
                pg8::EpiStore E{O, N, (s == 3) ? 1 : 0, (s == 3) ? RS : nullptr};
                pg8::gemm_phase<pg8::EpiStore, pg8::StaticOrder, true, true>(lds, g, S, E, tid);
            } else if (s == 4) {
                const float lambda_init = 0.8f - 0.6f * __expf(-0.3f * (float)l);
                float lam;
                { const float* q1 = args.in[9] + 32 * l; const float* k1 = args.in[10] + 32 * l; const float* q2 = args.in[11] + 32 * l; const float* k2 = args.in[12] + 32 * l;
                  float v = lane < 32 ? q1[lane] * k1[lane] : q2[lane - 32] * k2[lane - 32];
#pragma unroll
                  for (int o = 1; o < 32; o <<= 1) v += shx(v, lane, o);
                  const float s1 = __int_as_float(__builtin_amdgcn_readlane(__float_as_int(v), 0)), s2 = __int_as_float(__builtin_amdgcn_readlane(__float_as_int(v), 32)); lam = __expf(s1) - __expf(s2) + lambda_init; }
                LAS int* uw = (LAS int*)(lds + att::OFF_UNIT);
                unsigned* qctr = ctl + 64 * 4 * (l + DEPTH * rep);
#define NEXT_UNIT(q, n) if (tid == 0) *uw = (int)atomicAdd(qctr + 64 * (q), 1u); __syncthreads(); const int u = *uw; __syncthreads(); if (u >= (n)) break;
#ifndef NO_B
                for (;;) { NEXT_UNIT(0, 1024)
                    const int qb = 7 - u / 128, w_ = u % 128, b = 31 - w_ / 4, hh = w_ % 4;
                    att::attn_unit<1>(lds, PROJ, YB, b, qb, 1152 + 64 * hh, 1408 + 64 * hh, 1664 + 64 * hh, 384 + 64 * hh, nullptr,
                                      __builtin_amdgcn_exp2f(-2.0f * (float)(hh + 1)) * LOG2E, lam, args.in[13] + 64 * l, 1.0f - lambda_init, tid); }
#endif
#ifndef NO_C
                for (;;) { NEXT_UNIT(1, 1536)
                    const int qb = 7 - u / 192, w_ = u % 192, b = 31 - w_ / 6, hc = w_ % 6;
                    att::attn_unit<2>(lds, PROJ, YB, b, qb, 1920 + 64 * hc, 2304 + 64 * hc, 2688 + 64 * hc, 640 + 64 * hc, nullptr, 0.f, 0.f, nullptr, 0.f, tid); }
#endif
#ifndef NO_A
                for (;;) { NEXT_UNIT(2, 1536)
                    const int b = 31 - u / 48, r_ = u % 48, ha = r_ / 8, qb = r_ % 8;
                    att::attn_unit<0>(lds, PROJ, YB, b, qb, 64 * ha, 384 + 64 * ha, 768 + 64 * ha, 64 * ha, args.in[8] + (size_t)(l * 6 + ha) * 257, 0.f, 0.f, nullptr, 0.f, tid); }
#endif
#undef NEXT_UNIT
            } else {
                const float* gpost = (s == 2) ? args.in[5] + DM * l : (s == 6) ? args.in[15] + DM * l : args.in[20] + DM * l;
                const float wgt = (s == 6) ? 1.0f : 0.5f;
                if (l == 0 && s == 2) norm_rows<true, false, true>(args.in[0], FB, wgt, gpost, XB, RS, gw, ngw, lane, ph & 1);
                else if (l == DEPTH - 1 && s == 9) norm_rows<true, true, false>(XB, FB, wgt, gpost, args.out, nullptr, gw, ngw, lane, ph & 1);
                else norm_rows<true, true, true>(XB, FB, wgt, gpost, XB, RS, gw, ngw, lane, ph & 1);
            }
        }
        if (phx + 1 < hi_x) {
            volatile LAS unsigned* bst = (volatile LAS unsigned*)(lds + MISC_OFF) + 8;
            if (phx == lo) {
                cg::this_grid().sync();
                (void)xcd_barrier_post(ctl + CW_BAR, bst);
            } else { XcdBarrier xb; xb.bar = ctl + CW_BAR; xb.x = xb_xcc_id(); xb.st = bst; xcd_barrier(xb); }
        }
#undef args
    }
}

extern "C" void kernel_launch(void* const* d_in, const int* in_sizes, int n_in, void* d_out, int out_size, void* d_ws, size_t ws_size, hipStream_t stream) {
    static int grid = 0;
    if (grid == 0) {
        if (n_in != 21 || out_size != MTOK * DM || ws_size < WS_END) { fprintf(stderr, "kernel_launch: unexpected shapes (n_in %d, out %d, ws %zu)\n", n_in, out_size, ws_size); grid = -1; return; }
        int dev = 0, cus = 0, per_cu = 0;
        hipGetDevice(&dev); hipDeviceGetAttribute(&cus, hipDeviceAttributeMultiprocessorCount, dev);
        if (hipFuncSetAttribute((const void*)mega_fwd, hipFuncAttributeMaxDynamicSharedMemorySize, LDS_BYTES) != hipSuccess) { fprintf(stderr, "kernel_launch: hipFuncSetAttribute failed\n"); }
        if (hipOccupancyMaxActiveBlocksPerMultiprocessor(&per_cu, (const void*)mega_fwd, NTHREADS, LDS_BYTES) != hipSuccess || per_cu < 1) { fprintf(stderr, "kernel_launch: occupancy query gave %d\n", per_cu); per_cu = 1; }
        (void)hipGetLastError();
        grid = cus * 1;
        fprintf(stderr, "kernel_launch: grid %d (per_cu %d)\n", grid, per_cu);
    }
    if (grid < 0) return;
    Args a{};
    for (int i = 0; i < 21; ++i) a.in[i] = (const float*)d_in[i];
    a.out = (float*)d_out; a.ws = (unsigned char*)d_ws;
#if MULTI_LAUNCH
    for (int ph = 0; ph < NPH; ++ph) { a.ph_lo = ph; a.ph_hi = ph + 1; hipLaunchKernelGGL(mega_fwd, dim3(grid), dim3(NTHREADS), LDS_BYTES, stream, a); }
#else
    a.ph_lo = 0; a.ph_hi = NPH;
    void* kargs[] = {&a};
    hipError_t e = hipLaunchCooperativeKernel((const void*)mega_fwd, dim3(grid), dim3(NTHREADS), kargs, LDS_BYTES, stream);
    if (e != hipSuccess) fprintf(stderr, "kernel_launch: cooperative launch failed: %s (grid %d)\n", hipGetErrorString(e), grid);
#endif
}
```

```cpp
#include <hip/hip_runtime.h>
#include <hip/hip_cooperative_groups.h>
#include <cstdio>
#include <cstdint>
namespace cg = cooperative_groups;
namespace pg8 {
#define PG8_LAS __attribute__((address_space(3)))
typedef unsigned short bf16_t;
typedef short bf16x8 __attribute__((ext_vector_type(8)));
typedef float f32x4 __attribute__((ext_vector_type(4)));
typedef unsigned u32x4 __attribute__((ext_vector_type(4)));
constexpr int BM = 256, BK = 64, HALF = 128, HTB = HALF * BK * 2  , STAGE_BYTES = 8 * HTB, NXCD = 8, WGM = 8;

__host__ __device__ __forceinline__ int lds_byte(int r, int c) { const int st = (r >> 4) * 2 + (c >> 5), rr = r & 15, cc = c & 31, ob = rr * 64 + cc * 2; return st * 1024 + (ob ^ (((ob >> 9) & 1) << 5)); }
__host__ __device__ __forceinline__ void stage_rc(int b, int& R, int& C) { const int st = b / 1024, sb = b % 1024, swz = sb ^ (((sb >> 9) & 1) << 5); R = (st >> 1) * 16 + swz / 64; C = (st & 1) * 32 + (swz % 64) / 2; }
__host__ __device__ __forceinline__ int perm32(int rho) { const int n = rho >> 4, i = rho & 15; return 8 * (i >> 2) + 4 * n + (i & 3); }

struct Unit { int pm, pn; };
struct Gemm { const bf16_t* A; const bf16_t* Bt; int M, N, K; };

struct StaticOrder {
    int nM, nN, nwg, G, c, rev;
    __host__ __device__ void init(int M, int N, int G_, int c_, int rev_ = 0) { nM = M / BM; nN = N / BM; nwg = nM * nN; G = G_; c = c_; rev = rev_; }
    __host__ __device__ bool next(int i, Unit& u) const {
        const long L = (long)i * G + c; if (L >= nwg) return false;
        int wgid = (int)L; { const int q = nwg / NXCD, r = nwg % NXCD, xcd = wgid % NXCD, off = wgid / NXCD; wgid = (xcd < r ? xcd * (q + 1) : r * (q + 1) + (xcd - r) * q) + off; }
        const int nig = WGM * nN, gid = wgid / nig, fm = gid * WGM, gsz = (nM - fm) < WGM ? (nM - fm) : WGM;
        u.pm = fm + ((wgid % nig) % gsz); u.pn = (wgid % nig) / gsz; if (rev) u.pm = nM - 1 - u.pm; return true;
    }
    __device__ __forceinline__ void a_ready(const Unit&) const {}
    __device__ __forceinline__ void done(const Unit&) const {}
};

__device__ __forceinline__ unsigned cvt_pk_bf16(float lo, float hi) { unsigned r; asm volatile("v_cvt_pk_bf16_f32 %0, %1, %2" : "=v"(r) : "v"(lo), "v"(hi)); return r; }
typedef float f32x2 __attribute__((ext_vector_type(2)));
struct EpiStore {
    static constexpr bool PERM = true, AFTER_DRAIN = false;
    bf16_t* O; int ldc; int qscale; const float* rs;
    __device__ __forceinline__ void operator()(const f32x4 (&acc)[2][2][4][2], const Unit& u, int wr, int wc, int fr, int fq) const {
        const int row0 = u.pm * BM + wr * 64 + fr, col0 = u.pn * BM + wc * 32 + 8 * fq;
        float sc[2] = {1.f, 1.f};
        if (qscale) {
#pragma unroll
            for (int bj = 0; bj < 2; ++bj) { const int hx = 2 * u.pn + bj;
                sc[bj] = (hx <= 2 || (hx >= 15 && hx <= 17)) ? 0.125f * 1.4426950408889634f : ((hx == 9 || hx == 10) ? 0.17677669529663687f * 1.4426950408889634f : 1.f); }
        }
#pragma unroll
        for (int ai = 0; ai < 2; ++ai)
#pragma unroll
            for (int m = 0; m < 4; ++m) { bf16_t* rowp = O + (size_t)(row0 + ai * HALF + m * 16) * ldc + col0; const float rv = rs ? rs[row0 + ai * HALF + m * 16] : 1.f;
#pragma unroll
                for (int bj = 0; bj < 2; ++bj) { const float sb = sc[bj] * rv; const f32x4 v0 = acc[ai][bj][m][0] * sb, v1 = acc[ai][bj][m][1] * sb;
                    u32x4 w; w.x = cvt_pk_bf16(v0[0], v0[1]); w.y = cvt_pk_bf16(v0[2], v0[3]); w.z = cvt_pk_bf16(v1[0], v1[1]); w.w = cvt_pk_bf16(v1[2], v1[3]);
                    *(u32x4*)(rowp + bj * HALF) = w; } }
    }
};
struct EpiSwiGLU {
    static constexpr bool PERM = true, AFTER_DRAIN = false;
    bf16_t* O; int ldc; const float* rs;
    static __device__ __forceinline__ float sw(float g, float u) { return g * u * __builtin_amdgcn_rcpf(1.0f + __builtin_amdgcn_exp2f(-1.4426950408889634f * g)); }
    __device__ __forceinline__ void operator()(const f32x4 (&acc)[2][2][4][2], const Unit& u, int wr, int wc, int fr, int fq) const {
        const int row0 = u.pm * BM + wr * 64 + fr, col0 = u.pn * HALF + wc * 32 + 8 * fq;
#pragma unroll
        for (int ai = 0; ai < 2; ++ai)
#pragma unroll
            for (int m = 0; m < 4; ++m) { bf16_t* rowp = O + (size_t)(row0 + ai * HALF + m * 16) * ldc + col0;
                const float rv = rs[row0 + ai * HALF + m * 16];
                const f32x4 g0 = acc[ai][0][m][0] * rv, g1 = acc[ai][0][m][1] * rv, u0 = acc[ai][1][m][0] * rv, u1 = acc[ai][1][m][1] * rv;
                u32x4 w; w.x = cvt_pk_bf16(sw(g0[0], u0[0]), sw(g0[1], u0[1])); w.y = cvt_pk_bf16(sw(g0[2], u0[2]), sw(g0[3], u0[3]));
                w.z = cvt_pk_bf16(sw(g1[0], u1[0]), sw(g1[1], u1[1])); w.w = cvt_pk_bf16(sw(g1[2], u1[2]), sw(g1[3], u1[3]));
                *(u32x4*)rowp = w; }
    }
};

template <class Epi, class Sched, bool ALIGN_EPI = false, bool SP2 = false>
__device__ __forceinline__ void gemm_phase(PG8_LAS unsigned char* lds, const Gemm g, const Sched& S, const Epi& E, const int tid) {
    const int wid = __builtin_amdgcn_readfirstlane(tid >> 6), lane = tid & 63, wr = wid >> 2, wc = wid & 3, fr = lane & 15, fq = lane >> 4;
    const int K = g.K, nt = K / BK;
    unsigned voffA[2], voffB[2];
#pragma unroll
    for (int i = 0; i < 2; ++i) { int R, C; stage_rc(tid * 16 + i * 8192, R, C); const int Rb = Epi::PERM ? ((R & ~31) + perm32(R & 31)) : R;
        voffA[i] = (unsigned)(R * K + C) * 2u; voffB[i] = (unsigned)(Rb * K + C) * 2u; }
    const size_t kstep = (size_t)(BK * 2);
    const size_t hstep = (size_t)HALF * K * 2;
    const size_t tstep = 2 * hstep;
    const unsigned ldsw = (unsigned)wid * 1024u;
    const int aoff = lds_byte(wr * 64 + fr, fq * 8), boff = lds_byte(wc * 32 + fr, fq * 8);
#define PG8_SA(b, h) (((b) * 2 + (h)) * HTB)
#define PG8_SB(b, h) ((4 + (b) * 2 + (h)) * HTB)
#define PG8_STAGE(bufoff, gbase, voff) do { _Pragma("unroll") for (int _i = 0; _i < 2; ++_i) \
        __builtin_amdgcn_global_load_lds((const unsigned*)((const char*)(gbase) + (voff)[_i]), (PG8_LAS unsigned*)(lds + (bufoff) + ldsw + _i * 8192), 16, 0, 0); } while (0)
#define PG8_LDA(dst, b, h) do { _Pragma("unroll") for (int m = 0; m < 4; ++m) _Pragma("unroll") for (int k = 0; k < 2; ++k) dst[m][k] = *(const PG8_LAS bf16x8*)(lds + PG8_SA(b, h) + aoff + m * 2048 + k * 1024); } while (0)
#define PG8_LDB(dst, b, h) do { _Pragma("unroll") for (int n = 0; n < 2; ++n) _Pragma("unroll") for (int k = 0; k < 2; ++k) dst[n][k] = *(const PG8_LAS bf16x8*)(lds + PG8_SB(b, h) + boff + n * 2048 + k * 1024); } while (0)
#define PG8_MMA(ai, bj, At, Bt) do { __builtin_amdgcn_s_setprio(1); _Pragma("unroll") for (int m = 0; m < 4; ++m) _Pragma("unroll") for (int n = 0; n < 2; ++n) _Pragma("unroll") for (int k = 0; k < 2; ++k) \
        acc[ai][bj][m][n] = __builtin_amdgcn_mfma_f32_16x16x32_bf16(Bt[n][k], At[m][k], acc[ai][bj][m][n], 0, 0, 0); __builtin_amdgcn_s_setprio(0); } while (0)
#define PG8_WAIT_V(n) asm volatile("s_waitcnt vmcnt(" #n ")" ::: "memory")
#define PG8_WAIT_L(n) asm volatile("s_waitcnt lgkmcnt(" #n ")" ::: "memory")
#define PG8_BAR __builtin_amdgcn_s_barrier()
#define PG8_SCHED __builtin_amdgcn_sched_barrier(0)
    Unit cur, nxt; int ui = 0;
    if (!S.next(0, cur)) return;
    f32x4 acc[2][2][4][2];
#pragma unroll
    for (int a = 0; a < 2; ++a)
#pragma unroll
        for (int b = 0; b < 2; ++b)
#pragma unroll
            for (int m = 0; m < 4; ++m)
#pragma unroll
                for (int n = 0; n < 2; ++n) acc[a][b][m][n] = (f32x4){0.f, 0.f, 0.f, 0.f};
    bf16x8 At[4][2], B0[2][2], B1[2][2];
    const char* cA = (const char*)g.A + (size_t)cur.pm * tstep; const char* cB = (const char*)g.Bt + (size_t)cur.pn * tstep;
    S.a_ready(cur);
    if constexpr (SP2) {
        PG8_STAGE(PG8_SB(0, 0), cB, voffB); PG8_STAGE(PG8_SB(0, 1), cB + hstep, voffB); PG8_STAGE(PG8_SA(0, 0), cA, voffA); PG8_STAGE(PG8_SA(0, 1), cA + hstep, voffA);
        if (wr == 1) PG8_BAR;
        PG8_WAIT_V(2); PG8_BAR;
        PG8_STAGE(PG8_SB(1, 0), cB + kstep, voffB); PG8_STAGE(PG8_SA(1, 0), cA + kstep, voffA); PG8_STAGE(PG8_SB(1, 1), cB + hstep + kstep, voffB);
        PG8_WAIT_V(6); PG8_BAR;
    } else {
        PG8_STAGE(PG8_SB(0, 0), cB, voffB); PG8_STAGE(PG8_SA(0, 0), cA, voffA); PG8_STAGE(PG8_SB(0, 1), cB + hstep, voffB); PG8_STAGE(PG8_SA(0, 1), cA + hstep, voffA);
        if (wr == 1) PG8_BAR;
        PG8_WAIT_V(4); PG8_BAR;
        PG8_STAGE(PG8_SB(1, 0), cB + kstep, voffB); PG8_STAGE(PG8_SA(1, 0), cA + kstep, voffA); PG8_STAGE(PG8_SB(1, 1), cB + hstep + kstep, voffB);
        PG8_WAIT_V(6); PG8_BAR;
    }
    for (;;) {
        const bool has_next = S.next(ui + 1, nxt);
        const char* nA = has_next ? (const char*)g.A + (size_t)nxt.pm * tstep : cA; const char* nB = has_next ? (const char*)g.Bt + (size_t)nxt.pn * tstep : cB;
        for (int t = 0; t < nt; t += 2) {
            const bool last = (t == nt - 2);
            const char* a1 = cA + (size_t)(t + 1) * kstep;
            const char* a2 = last ? nA : cA + (size_t)(t + 2) * kstep; const char* b2 = last ? nB : cB + (size_t)(t + 2) * kstep;
            const char* a3 = a2 + kstep; const char* b3 = b2 + kstep;
            if (last && has_next) S.a_ready(nxt);
            if constexpr (SP2) {
            PG8_LDB(B0, 0, 0); PG8_LDB(B1, 0, 1); PG8_SCHED; PG8_LDA(At, 0, 0); PG8_STAGE(PG8_SA(1, 1), a1 + hstep, voffA);
            PG8_WAIT_V(8); PG8_WAIT_L(0); PG8_BAR; PG8_MMA(0, 0, At, B0); PG8_MMA(0, 1, At, B1); PG8_BAR; PG8_SCHED;
            PG8_LDA(At, 0, 1); PG8_STAGE(PG8_SB(0, 0), b2, voffB); PG8_STAGE(PG8_SB(0, 1), b2 + hstep, voffB); PG8_STAGE(PG8_SA(0, 0), a2, voffA);
            PG8_WAIT_V(8); PG8_WAIT_L(0); PG8_BAR; PG8_MMA(1, 0, At, B0); PG8_MMA(1, 1, At, B1); PG8_BAR; PG8_SCHED;
            PG8_LDB(B0, 1, 0); PG8_LDB(B1, 1, 1); PG8_SCHED; PG8_LDA(At, 1, 0); PG8_STAGE(PG8_SA(0, 1), a2 + hstep, voffA);
            PG8_WAIT_V(8); PG8_WAIT_L(0); PG8_BAR; PG8_MMA(0, 0, At, B0); PG8_MMA(0, 1, At, B1); PG8_BAR; PG8_SCHED;
            PG8_LDA(At, 1, 1); PG8_STAGE(PG8_SB(1, 0), b3, voffB); PG8_STAGE(PG8_SB(1, 1), b3 + hstep, voffB); PG8_STAGE(PG8_SA(1, 0), a3, voffA);
            PG8_WAIT_V(8); PG8_WAIT_L(0); PG8_BAR; PG8_MMA(1, 0, At, B0); PG8_MMA(1, 1, At, B1); PG8_BAR; PG8_SCHED;
            } else {
            PG8_LDB(B0, 0, 0); PG8_SCHED; PG8_LDA(At, 0, 0); PG8_STAGE(PG8_SA(1, 1), a1 + hstep, voffA);
            PG8_WAIT_L(8); PG8_BAR; PG8_WAIT_L(0); PG8_MMA(0, 0, At, B0); PG8_BAR; PG8_SCHED;
            PG8_LDB(B1, 0, 1); PG8_STAGE(PG8_SB(0, 0), b2, voffB);
            PG8_BAR; PG8_WAIT_L(0); PG8_MMA(0, 1, At, B1); PG8_BAR;
            PG8_LDA(At, 0, 1); PG8_STAGE(PG8_SA(0, 0), a2, voffA);
            PG8_BAR; PG8_WAIT_L(0); PG8_MMA(1, 0, At, B0); PG8_BAR; PG8_SCHED;
            PG8_STAGE(PG8_SB(0, 1), b2 + hstep, voffB);
            PG8_WAIT_V(6); PG8_BAR; PG8_MMA(1, 1, At, B1); PG8_BAR;
            PG8_LDB(B0, 1, 0); PG8_SCHED; PG8_LDA(At, 1, 0); PG8_STAGE(PG8_SA(0, 1), a2 + hstep, voffA);
            PG8_WAIT_L(8); PG8_BAR; PG8_WAIT_L(0); PG8_MMA(0, 0, At, B0); PG8_BAR; PG8_SCHED;
            PG8_LDB(B1, 1, 1); PG8_STAGE(PG8_SB(1, 0), b3, voffB);
            PG8_BAR; PG8_WAIT_L(0); PG8_MMA(0, 1, At, B1); PG8_BAR;
            PG8_LDA(At, 1, 1); PG8_STAGE(PG8_SA(1, 0), a3, voffA);
            PG8_BAR; PG8_WAIT_L(0); PG8_MMA(1, 0, At, B0); PG8_BAR; PG8_SCHED;
            PG8_STAGE(PG8_SB(1, 1), b3 + hstep, voffB);
            PG8_WAIT_V(6); PG8_BAR; PG8_MMA(1, 1, At, B1); PG8_BAR;
            }
        }
        if constexpr (ALIGN_EPI) { if (wr == 0) PG8_BAR; }
        if constexpr (!Epi::AFTER_DRAIN) { E(acc, cur, wr, wc, fr, fq); S.done(cur); }
        if (!has_next) break;
#pragma unroll
        for (int a = 0; a < 2; ++a)
#pragma unroll
            for (int b = 0; b < 2; ++b)
#pragma unroll
                for (int m = 0; m < 4; ++m)
#pragma unroll
                    for (int n = 0; n < 2; ++n) acc[a][b][m][n] = (f32x4){0.f, 0.f, 0.f, 0.f};
        cur = nxt; cA = nA; cB = nB; ++ui;
        if constexpr (ALIGN_EPI) { if (wr == 1) PG8_BAR; }
    }
    PG8_WAIT_V(0);
    if constexpr (!ALIGN_EPI) { if (wr == 0) PG8_BAR; }
    PG8_BAR;
    if constexpr (Epi::AFTER_DRAIN) { E.fused(acc, cur, wr, wc, fr, fq, lds, wid, lane); S.done(cur); }
#undef PG8_SA
#undef PG8_SB
#undef PG8_STAGE
#undef PG8_LDA
#undef PG8_LDB
#undef PG8_MMA
#undef PG8_WAIT_V
#undef PG8_WAIT_L
#undef PG8_BAR
#undef PG8_SCHED
}
}

#ifndef MULTI_LAUNCH
#define MULTI_LAUNCH 0
#endif
constexpr int BATCH = 32, SEQ = 2048, DM = 1024, MTOK = BATCH * SEQ, DFF = 2816, NIN = 3072, DEPTH = 2, NGU = 2 * DFF;
constexpr float NORM_EPS = 1e-6f;
constexpr float LOG2E = 1.4426950408889634f;
constexpr int NPH = 1 + 10 * DEPTH;
constexpr int NTHREADS = 512, NWAVES = 8;
constexpr size_t MiB = 1u << 20;
constexpr size_t WS_CTL = 0;
constexpr size_t WS_W = 1 * MiB;
constexpr size_t WL_GU1 = 0, WL_D1 = 11 * MiB, WL_IN = WL_D1 + 11 * MiB / 2, WL_OUT = WL_IN + 6 * MiB, WL_GU2 = WL_OUT + 2 * MiB, WL_D2 = WL_GU2 + 11 * MiB, WL_SIZE = WL_D2 + 11 * MiB / 2;
static_assert(WL_SIZE == 41 * MiB, "weights per layer");
constexpr size_t WS_XN = 84 * MiB, WS_F = 212 * MiB, WS_Y = 340 * MiB, WS_H = 468 * MiB, WS_XB = 852 * MiB, WS_END = 980 * MiB;
static_assert(WS_W + DEPTH * WL_SIZE <= WS_XN, "ws map");
constexpr int RING_BYTES = 131072, LDS_BYTES = 147456, MISC_OFF = RING_BYTES;

#define LAS __attribute__((address_space(3)))
typedef unsigned short bf16_t;
typedef unsigned v4u __attribute__((ext_vector_type(4)));
typedef unsigned v2u __attribute__((ext_vector_type(2)));
typedef float f32x4 __attribute__((ext_vector_type(4)));
typedef float f32x2_t __attribute__((ext_vector_type(2)));
typedef __bf16 bf16x2_t __attribute__((ext_vector_type(2)));
typedef short bf16x8 __attribute__((ext_vector_type(8)));
typedef short s16x4 __attribute__((ext_vector_type(4)));
typedef float f32x16 __attribute__((ext_vector_type(16)));
#define LDS_WAIT() asm volatile("s_waitcnt lgkmcnt(0)" ::: "memory")

__device__ __forceinline__ unsigned pk2(float lo, float hi) { f32x2_t v = {lo, hi}; bf16x2_t b = __builtin_convertvector(v, bf16x2_t); return __builtin_bit_cast(unsigned, b); }
__device__ __forceinline__ float bf_lo(unsigned w) { return __uint_as_float(w << 16); }
__device__ __forceinline__ float bf_hi(unsigned w) { return __uint_as_float(w & 0xffff0000u); }
__device__ __forceinline__ float shx(float v, int lane, int o) { return __int_as_float(__builtin_amdgcn_ds_bpermute((lane ^ o) << 2, __float_as_int(v))); }
__device__ __forceinline__ float wave_sum(float v, int lane) {
#pragma unroll
    for (int o = 1; o < 64; o <<= 1) v += shx(v, lane, o);
    return v;
}

__device__ __forceinline__ void p0_transpose_item(const float* W, int K, int N, bf16_t* WT, int gu, LAS float* scr, int item, int lane, const float* gk) {
    const int nblk = N / 32, kb = item / nblk, nb = item % nblk, k0 = 64 * kb, n0 = 32 * nb;
#pragma unroll 8
    for (int i = 0; i < 32; ++i) { const int kk = 2 * i + (lane >> 5); const float gv = gk ? gk[k0 + kk] : 1.f; scr[kk * 33 + (lane & 31)] = W[(size_t)(k0 + kk) * N + n0 + (lane & 31)] * gv; }
    LDS_WAIT(); asm volatile("" ::: "memory");
    const int c = lane & 7;
    const int r0 = gu ? (256 * (n0 >> 7) + (n0 & 127) + (gu == 2 ? 128 : 0)) : n0;
#pragma unroll
    for (int j = 0; j < 4; ++j) { const int n = (lane >> 3) + 8 * j; const LAS float* s = scr + (8 * c) * 33 + n;
        v4u o; o.x = pk2(s[0 * 33], s[1 * 33]); o.y = pk2(s[2 * 33], s[3 * 33]); o.z = pk2(s[4 * 33], s[5 * 33]); o.w = pk2(s[6 * 33], s[7 * 33]);
        *(v4u*)(WT + (size_t)(r0 + n) * K + k0 + 8 * c) = o; }
    LDS_WAIT(); asm volatile("" ::: "memory");
}

__device__ __forceinline__ float dpp_x(float v, const int ctrl) { return v; }
#define DPP_ADD(v, ctrl) (v) += __int_as_float(__builtin_amdgcn_update_dpp(0, __float_as_int(v), (ctrl), 0xf, 0xf, true))
__device__ __forceinline__ float wave_sum_fast(float v) {
    DPP_ADD(v, 0xB1);
    DPP_ADD(v, 0x4E);
    DPP_ADD(v, 0x141);
    DPP_ADD(v, 0x140);
    v += __int_as_float(__builtin_amdgcn_ds_swizzle(__float_as_int(v), 0x401F));
    auto rr = __builtin_amdgcn_permlane32_swap(__float_as_uint(v), __float_as_uint(v), false, false);
    return __uint_as_float(rr[0]) + __uint_as_float(rr[1]);
}
template <bool HAS_F, bool XS16>
struct RawRows { static constexpr int NR = XS16 ? 4 : 2;
    f32x4 xf[XS16 ? 1 : NR][XS16 ? 1 : 4]; v2u xh[XS16 ? NR : 1][XS16 ? 4 : 1]; v2u fh[HAS_F ? NR : 1][HAS_F ? 4 : 1]; };
template <bool HAS_F, bool XS16>
__device__ __forceinline__ void norm_load(RawRows<HAS_F, XS16>& R, const void* xsrc_, const bf16_t* F, int row, int lane) {
    constexpr int NR = RawRows<HAS_F, XS16>::NR;
#pragma unroll
    for (int q = 0; q < NR; ++q) {
        if (XS16) { const v2u* xr = (const v2u*)((const bf16_t*)xsrc_ + (size_t)(row + q) * DM) + lane;
#pragma unroll
            for (int j = 0; j < 4; ++j) R.xh[XS16 ? q : 0][XS16 ? j : 0] = xr[64 * j]; }
        else { const f32x4* xr = (const f32x4*)((const float*)xsrc_ + (size_t)(row + q) * DM) + lane;
#pragma unroll
            for (int j = 0; j < 4; ++j) R.xf[XS16 ? 0 : q][XS16 ? 0 : j] = xr[64 * j]; }
        if (HAS_F) { const v2u* fp = (const v2u*)(F + (size_t)(row + q) * DM) + lane;
#pragma unroll
            for (int j = 0; j < 4; ++j) R.fh[HAS_F ? q : 0][HAS_F ? j : 0] = fp[64 * j]; }
    }
}
template <bool HAS_F, bool XS16, bool XD16>
__device__ __forceinline__ void norm_rows(const void* xsrc_, const bf16_t* F, float w, const float* gpost, void* xdst_, float* RS, int gw, int ngw, int lane, int rev) {
    constexpr int NR = RawRows<HAS_F, XS16>::NR;
    f32x4 gp[4];
#pragma unroll
    for (int j = 0; j < 4; ++j) gp[j] = HAS_F ? *((const f32x4*)gpost + lane + 64 * j) : (f32x4){0.f, 0.f, 0.f, 0.f};
    const int step = NR * ngw;
    RawRows<HAS_F, XS16> cur;
#define ROWMAP(r_) (rev ? (MTOK - NR - (r_)) : (r_))
    norm_load<HAS_F, XS16>(cur, xsrc_, F, ROWMAP(NR * gw), lane);
    for (int row_ = NR * gw; row_ < MTOK; row_ += step) {
        RawRows<HAS_F, XS16> nxt; const bool hn = row_ + step < MTOK; const int row = ROWMAP(row_);
        if (hn) norm_load<HAS_F, XS16>(nxt, xsrc_, F, ROWMAP(row_ + step), lane);
        f32x4 v[NR][4];
#pragma unroll
        for (int q = 0; q < NR; ++q)
#pragma unroll
            for (int j = 0; j < 4; ++j) { if (XS16) { const v2u t = cur.xh[XS16 ? q : 0][XS16 ? j : 0]; v[q][j] = (f32x4){bf_lo(t.x), bf_hi(t.x), bf_lo(t.y), bf_hi(t.y)}; } else v[q][j] = cur.xf[XS16 ? 0 : q][XS16 ? 0 : j]; }
        if (HAS_F) {
            float ss[NR];
#pragma unroll
            for (int q = 0; q < NR; ++q) { ss[q] = 0.f;
#pragma unroll
                for (int j = 0; j < 4; ++j) { const v2u t = cur.fh[HAS_F ? q : 0][HAS_F ? j : 0]; const f32x4 f = (f32x4){bf_lo(t.x), bf_hi(t.x), bf_lo(t.y), bf_hi(t.y)}; ss[q] += (f.x * f.x + f.y * f.y) + (f.z * f.z + f.w * f.w); } }
#pragma unroll
            for (int q = 0; q < NR; ++q) ss[q] = wave_sum_fast(ss[q]);
#pragma unroll
            for (int q = 0; q < NR; ++q) { const float rs = w * __builtin_amdgcn_rsqf(ss[q] * (1.f / DM) + NORM_EPS);
#pragma unroll
                for (int j = 0; j < 4; ++j) { const v2u t = cur.fh[HAS_F ? q : 0][HAS_F ? j : 0]; const f32x4 f = (f32x4){bf_lo(t.x), bf_hi(t.x), bf_lo(t.y), bf_hi(t.y)}; v[q][j] = v[q][j] + (f * rs) * gp[j]; } }
        }
        if (XD16) {
#pragma unroll
            for (int q = 0; q < NR; ++q) { v2u* xo = (v2u*)((bf16_t*)xdst_ + (size_t)(row + q) * DM) + lane;
#pragma unroll
                for (int j = 0; j < 4; ++j) { v2u t; t.x = pk2(v[q][j].x, v[q][j].y); t.y = pk2(v[q][j].z, v[q][j].w); xo[64 * j] = t;
                    v[q][j] = (f32x4){bf_lo(t.x), bf_hi(t.x), bf_lo(t.y), bf_hi(t.y)}; } }
        } else {
#pragma unroll
            for (int q = 0; q < NR; ++q) { f32x4* xo = (f32x4*)((float*)xdst_ + (size_t)(row + q) * DM) + lane;
#pragma unroll
                for (int j = 0; j < 4; ++j) xo[64 * j] = v[q][j]; }
        }
        if (RS) {
            float s2[NR];
#pragma unroll
            for (int q = 0; q < NR; ++q) { s2[q] = 0.f;
#pragma unroll
                for (int j = 0; j < 4; ++j) s2[q] += (v[q][j].x * v[q][j].x + v[q][j].y * v[q][j].y) + (v[q][j].z * v[q][j].z + v[q][j].w * v[q][j].w); }
#pragma unroll
            for (int q = 0; q < NR; ++q) s2[q] = wave_sum_fast(s2[q]);
            float mine = s2[0];
#pragma unroll
            for (int q = 1; q < NR; ++q) mine = (lane == q) ? s2[q] : mine;
            if (lane < NR) RS[row + lane] = __builtin_amdgcn_rsqf(mine * (1.f / DM) + NORM_EPS);
        }
        if (hn) cur = nxt;
    }
#undef ROWMAP
}

namespace att {
constexpr int KROW = 144, TILEB = 64 * KROW;
constexpr int OFF_K = 0, OFF_V = 2 * TILEB, OFF_BIAS = 4 * TILEB, OFF_UNIT = OFF_BIAS + 1040;
#define MFMA32(a, b, c) __builtin_amdgcn_mfma_f32_32x32x16_bf16((a), (b), (c), 0, 0, 0)
typedef short v4i16_t __attribute__((ext_vector_type(4)));
__device__ __forceinline__ s16x4 vtr(LAS const unsigned char* p) { return __builtin_bit_cast(s16x4, __builtin_amdgcn_ds_read_tr16_b64_v4i16((LAS v4i16_t*)p)); }
__device__ __forceinline__ void xswap(float v, float& v0, float& v1) { auto rr = __builtin_amdgcn_permlane32_swap(__float_as_uint(v), __float_as_uint(v), false, false); v0 = __uint_as_float(rr[0]); v1 = __uint_as_float(rr[1]); }
__device__ __forceinline__ float xmax(float v) { float a, b; xswap(v, a, b); return fmaxf(a, b); }
__device__ __forceinline__ float xsum(float v) { float a, b; xswap(v, a, b); return a + b; }
__device__ __forceinline__ bf16x8 packp(const f32x16& p, int s) {
    v4u w; w.x = pk2(p[8 * s], p[8 * s + 1]); w.y = pk2(p[8 * s + 2], p[8 * s + 3]); w.z = pk2(p[8 * s + 4], p[8 * s + 5]); w.w = pk2(p[8 * s + 6], p[8 * s + 7]);
    return __builtin_bit_cast(bf16x8, w);
}
template <int D0, int D1>
__device__ __forceinline__ f32x16 qk(LAS const unsigned char* kt, int sub, const bf16x8* qf, int r, int h) {
    f32x16 acc = {};
    LAS const unsigned char* kp = kt + (32 * sub + r) * KROW + 16 * h;
#pragma unroll
    for (int d0 = D0; d0 < D1; ++d0) { const bf16x8 kf = *(LAS const bf16x8*)(kp + 32 * d0); acc = MFMA32(kf, qf[d0], acc); }
    return acc;
}
__device__ __forceinline__ void pv(f32x16 (&O)[2], LAS const unsigned char* vt, int sub, const f32x16& p, int lane) {
    const int h = lane >> 5, i16 = lane & 15, q = i16 >> 2, pp = i16 & 3, blk = (lane >> 4) & 1;
    LAS const unsigned char* vp = vt + (32 * sub + 4 * h + q) * KROW + 32 * blk + 8 * pp;
#pragma unroll
    for (int s = 0; s < 2; ++s) {
        const bf16x8 pf = packp(p, s);
#pragma unroll
        for (int dblk = 0; dblk < 2; ++dblk) {
            const s16x4 lo = vtr(vp + (16 * s) * KROW + 64 * dblk), hi = vtr(vp + (16 * s + 8) * KROW + 64 * dblk);
            const bf16x8 vf = __builtin_shufflevector(lo, hi, 0, 1, 2, 3, 4, 5, 6, 7);
            O[dblk] = MFMA32(vf, pf, O[dblk]);
        }
    }
}
__device__ __forceinline__ void osm(f32x16& p0, f32x16& p1, float lbase, float& m, float& l, f32x16 (&O)[2]) {
#define MX2(a, b) __builtin_amdgcn_fmed3f((a), (b), 3.0e38f)
    float ra = MX2(p0[0], p1[0]), rb = MX2(p0[1], p1[1]);
#pragma unroll
    for (int i = 2; i < 16; i += 2) { ra = MX2(ra, MX2(p0[i], p1[i])); rb = MX2(rb, MX2(p0[i + 1], p1[i + 1])); }
    float rm = MX2(ra, rb);
#undef MX2
    rm = xmax(rm + lbase);
    if (__any(rm > m + 8.0f)) {
        const float mn = fmaxf(m, rm), alpha = __builtin_amdgcn_exp2f(m - mn); m = mn; l *= alpha;
#pragma unroll
        for (int i = 0; i < 16; ++i) { O[0][i] *= alpha; O[1][i] *= alpha; }
    }
    const float mm = m - lbase; float s = 0.f;
#pragma unroll
    for (int i = 0; i < 16; ++i) { p0[i] = __builtin_amdgcn_exp2f(p0[i] - mm); p1[i] = __builtin_amdgcn_exp2f(p1[i] - mm); s += p0[i] + p1[i]; }
    l += s;
}

template <int MODE>
__device__ __forceinline__ void attn_unit(LAS unsigned char* lds, const bf16_t* PROJ, bf16_t* Y, int b, int qb, int colQ, int colK, int colV, int colO,
                                          const float* relb, float slope2, float lam, const float* subg, float outscale, const int tid) {
    const int lane = tid & 63, r = lane & 31, h = lane >> 5; const int w = __builtin_amdgcn_readfirstlane(tid >> 6);
    const int tq0 = qb * 256 + 32 * w, t = tq0 + r;
    const size_t rowb = (size_t)b * SEQ;
    LAS unsigned char* Kb = lds + OFF_K; LAS unsigned char* Vb = lds + OFF_V; LAS float* biasl = (LAS float*)(lds + OFF_BIAS);
    const int c0 = 4 * qb;
    const int kt_lo = (MODE == 0) ? (c0 - 8 > 0 ? c0 - 8 : 0) : 0, kt_hi = c0 + 3, nt = kt_hi - kt_lo + 1;
    const int cw = c0 + (w >> 1);
    const int lrow = tid >> 3, lch = tid & 7;
    const bf16_t* kg = PROJ + (rowb + lrow) * NIN + colK + lch * 8;
    const bf16_t* vg = PROJ + (rowb + lrow) * NIN + colV + lch * 8;
    const int lofs = lrow * KROW + lch * 16;
#define KT(i) ((MODE == 2) ? (kt_hi - (i)) : (kt_lo + (i)))
    v4u kr = *(const v4u*)(kg + (size_t)KT(0) * 64 * NIN), vr = *(const v4u*)(vg + (size_t)KT(0) * 64 * NIN);
    if (MODE == 0) { if (tid < 257) biasl[tid] = relb[tid] * LOG2E; }
    bf16x8 qf[4];
    { const bf16_t* qp = PROJ + (rowb + t) * NIN + colQ + 8 * h;
#pragma unroll
      for (int d0 = 0; d0 < 4; ++d0) qf[d0] = *(const bf16x8*)(qp + 16 * d0); }
    *(LAS v4u*)(Kb + lofs) = kr; *(LAS v4u*)(Vb + lofs) = vr;
    __syncthreads();
    f32x16 O0[2] = {}, O1[2] = {};
    float m0 = -1e30f, l0 = 0.f, m1 = -1e30f, l1 = 0.f, Prun = 1.f;
    if (MODE == 1) asm volatile("" : "+v"(slope2));
    for (int i = 0; i < nt; ++i) {
        const int kt = KT(i), buf = i & 1;
        if (i + 1 < nt) { kr = *(const v4u*)(kg + (size_t)KT(i + 1) * 64 * NIN); vr = *(const v4u*)(vg + (size_t)KT(i + 1) * 64 * NIN); }
        LAS const unsigned char* ktile = Kb + buf * TILEB; LAS const unsigned char* vtile = Vb + buf * TILEB;
        int wdone = 0;
        if (MODE == 0) {
            if (kt >= cw - 8 && kt <= cw) {
                f32x16 p0 = qk<0, 4>(ktile, 0, qf, r, h), p1 = qk<0, 4>(ktile, 1, qf, r, h);
                float lb = 0.f;
                if (kt <= cw - 3) lb = biasl[256];
                else { const int d0 = t - (kt * 64 + 4 * h) + 128;
#pragma unroll
                    for (int j = 0; j < 16; ++j) { const int ko = (j & 3) + 8 * (j >> 2); int i0 = d0 - ko, i1 = d0 - ko - 32;
                        i0 = i0 < 0 ? 0 : (i0 > 256 ? 256 : i0); i1 = i1 < 0 ? 0 : (i1 > 256 ? 256 : i1);
                        p0[j] += biasl[i0]; p1[j] += biasl[i1]; }
                }
                osm(p0, p1, lb, m0, l0, O0);
                pv(O0, vtile, 0, p0, lane); pv(O0, vtile, 1, p1, lane);
            }
        } else if (MODE == 1) {
            if (kt <= cw) {
                const float dist0 = (float)(t - (kt * 64 + 4 * h));
                const bool diag = (kt == cw);
                const float lb = diag ? 0.f : -slope2 * dist0;
                { f32x16 p0 = qk<0, 2>(ktile, 0, qf, r, h), p1 = qk<0, 2>(ktile, 1, qf, r, h);
                  if (diag) {
#pragma unroll
                      for (int j = 0; j < 16; ++j) { const float ko = (float)((j & 3) + 8 * (j >> 2)); p0[j] -= slope2 * fabsf(dist0 - ko); p1[j] -= slope2 * fabsf(dist0 - ko - 32.f); }
                  } else {
#pragma unroll
                      for (int j = 0; j < 16; ++j) { const float ko = (float)((j & 3) + 8 * (j >> 2)); p0[j] = fmaf(slope2, ko, p0[j]); p1[j] = fmaf(slope2, ko + 32.f, p1[j]); }
                  }
                  osm(p0, p1, lb, m0, l0, O0); pv(O0, vtile, 0, p0, lane); pv(O0, vtile, 1, p1, lane); }
                { float dist1 = dist0; int vo = buf * TILEB; asm volatile("" : "+v"(dist1), "+s"(vo));
                  LAS const unsigned char* vtile1 = Vb + vo;
                  f32x16 p0 = qk<2, 4>(ktile, 0, qf, r, h), p1 = qk<2, 4>(ktile, 1, qf, r, h);
                  if (diag) {
#pragma unroll
                      for (int j = 0; j < 16; ++j) { const float ko = (float)((j & 3) + 8 * (j >> 2)); p0[j] -= slope2 * fabsf(dist1 - ko); p1[j] -= slope2 * fabsf(dist1 - ko - 32.f); }
                  } else {
#pragma unroll
                      for (int j = 0; j < 16; ++j) { const float ko = (float)((j & 3) + 8 * (j >> 2)); p0[j] = fmaf(slope2, ko, p0[j]); p1[j] = fmaf(slope2, ko + 32.f, p1[j]); }
                  }
                  osm(p0, p1, lb, m1, l1, O1); pv(O1, vtile1, 0, p0, lane); pv(O1, vtile1, 1, p1, lane); }
            }
        } else {
            if (!__all(Prun < 1e-30f)) {
#pragma unroll
                for (int sub = 1; sub >= 0; --sub) {
                    const int ks = kt * 64 + 32 * sub;
                    if (ks <= tq0) {
                        f32x16 a = qk<0, 4>(ktile, sub, qf, r, h); f32x16 om;
#pragma unroll
                        for (int j = 0; j < 16; ++j) { const float e = __builtin_amdgcn_exp2f(-a[j]), bt = __builtin_amdgcn_rcpf(1.0f + e); a[j] = bt; om[j] = 1.0f - bt; }
                        if (ks == tq0) {
                            const int thr = r - 4 * h;
#pragma unroll
                            for (int j = 0; j < 16; ++j) { const bool valid = ((j & 3) + 8 * (j >> 2)) < thr; om[j] = valid ? om[j] : 1.f; a[j] = valid ? a[j] : 0.f; }
                        }
                        float after = 1.f, carry[4];
#pragma unroll
                        for (int g = 3; g >= 0; --g) { const float G = (om[4 * g] * om[4 * g + 1]) * (om[4 * g + 2] * om[4 * g + 3]); float G0, G1; xswap(G, G0, G1);
                            carry[g] = (Prun * after) * (h == 0 ? G1 : 1.f); after *= G0 * G1; }
                        Prun *= after;
#pragma unroll
                        for (int g = 0; g < 4; ++g) { const float s3 = carry[g], s2 = s3 * om[4 * g + 3], s1 = s2 * om[4 * g + 2], s0 = s1 * om[4 * g + 1];
                            a[4 * g + 3] *= s3; a[4 * g + 2] *= s2; a[4 * g + 1] *= s1; a[4 * g] *= s0; }
                        pv(O0, vtile, sub, a, lane);
                    }
                }
            }
            wdone = __all(Prun < 1e-30f);
        }
        if (i + 1 < nt) { const int nb = (i + 1) & 1; *(LAS v4u*)(Kb + nb * TILEB + lofs) = kr; *(LAS v4u*)(Vb + nb * TILEB + lofs) = vr; }
        if (MODE == 2) { if (__syncthreads_and(wdone)) break; }
        else __syncthreads();
    }
#undef KT
    bf16_t* yp = Y + (rowb + t) * DM + colO + 4 * h;
    if (MODE == 0) { const float il = __builtin_amdgcn_rcpf(xsum(l0));
#pragma unroll
        for (int j = 0; j < 16; ++j) { O0[0][j] *= il; O0[1][j] *= il; }
    } else if (MODE == 1) {
        const float i0 = __builtin_amdgcn_rcpf(xsum(l0)), i1 = lam * __builtin_amdgcn_rcpf(xsum(l1)); float ss = 0.f;
#pragma unroll
        for (int j = 0; j < 16; ++j) { O0[0][j] = O0[0][j] * i0 - O1[0][j] * i1; O0[1][j] = O0[1][j] * i0 - O1[1][j] * i1; ss += O0[0][j] * O0[0][j] + O0[1][j] * O0[1][j]; }
        const float rs = __builtin_amdgcn_rsqf(xsum(ss) * (1.f / 64.f) + NORM_EPS) * outscale;
#pragma unroll
        for (int dblk = 0; dblk < 2; ++dblk)
#pragma unroll
            for (int g = 0; g < 4; ++g) { const f32x4 gg = *(const f32x4*)(subg + 32 * dblk + 8 * g + 4 * h);
                O0[dblk][4 * g] *= rs * gg.x; O0[dblk][4 * g + 1] *= rs * gg.y; O0[dblk][4 * g + 2] *= rs * gg.z; O0[dblk][4 * g + 3] *= rs * gg.w; }
    }
#pragma unroll
    for (int dblk = 0; dblk < 2; ++dblk)
#pragma unroll
        for (int g = 0; g < 4; ++g) { v2u o; o.x = pk2(O0[dblk][4 * g], O0[dblk][4 * g + 1]); o.y = pk2(O0[dblk][4 * g + 2], O0[dblk][4 * g + 3]);
            *(v2u*)(yp + 32 * dblk + 8 * g) = o; }
}
}

constexpr int CW_BAR = 4096;
#define XB_TMO      128
#define XB_XCNT(j)  (256  + 64 * (j))
#define XB_XSUB(j)  (1280 + 64 * (j))
#define XB_XGEN(j)  (2304 + 64 * (j))
#define XB_TOP      3328
#define XB_TOPGEN   3392
#define XCD_BAR_WORDS 3456
#define XB_SPIN_CAP (1u << 18)

__device__ __forceinline__ unsigned xb_ld(unsigned* p)              { return __hip_atomic_load(p, __ATOMIC_RELAXED, __HIP_MEMORY_SCOPE_AGENT); }
__device__ __forceinline__ unsigned xb_add(unsigned* p, unsigned v) { return __hip_atomic_fetch_add(p, v, __ATOMIC_RELAXED, __HIP_MEMORY_SCOPE_AGENT); }
__device__ __forceinline__ unsigned xb_xcc_id() { return (unsigned)__builtin_amdgcn_s_getreg((3 << 11) | 20) & 0xFu; }
#define XB_SPIN(cond, bar) do { unsigned _sp = 0; while (cond) { __builtin_amdgcn_s_sleep(1); \
    if ((++_sp & 255u) == 0u) { if (xb_ld(&(bar)[XB_TMO])) break; if (_sp > XB_SPIN_CAP) { atomicAdd(&(bar)[XB_TMO], 1u); break; } } } } while (0)

struct XcdBarrier {
    unsigned* bar; unsigned x;
    volatile LAS unsigned* st;
};

__device__ __forceinline__ XcdBarrier xcd_barrier_post(unsigned* bar, volatile LAS unsigned* st) {
    XcdBarrier b; b.bar = bar; b.x = xb_xcc_id(); b.st = st;
    if (threadIdx.x == 0) (void)xb_add(&bar[XB_XCNT(b.x)], 1u);
    return b;
}
__device__ __forceinline__ void xcd_barrier_complete(unsigned* bar, unsigned x, unsigned& nloc, unsigned& nx) {
    const unsigned G = gridDim.x * gridDim.y * gridDim.z;
    unsigned sum, cnt, mine, sp = 0u;
    for (;;) {
        sum = 0u; cnt = 0u; mine = 0u;
#pragma unroll
        for (unsigned j = 0; j < 16; ++j) { const unsigned c = xb_ld(&bar[XB_XCNT(j)]); sum += c; cnt += (c > 0u) ? 1u : 0u; mine = (j == x) ? c : mine; }
        if (sum == G) break;
        __builtin_amdgcn_s_sleep(1);
        if ((++sp & 255u) == 0u) { if (xb_ld(&bar[XB_TMO])) break; if (sp > XB_SPIN_CAP) { atomicAdd(&bar[XB_TMO], 1u); break; } }
    }
    nloc = mine > 0u ? mine : 1u; nx = cnt > 0u ? cnt : 1u;
}

__device__ __forceinline__ void xcd_barrier(const XcdBarrier& b) {
    asm volatile("s_waitcnt vmcnt(0)" ::: "memory");
    __syncthreads();
    if (threadIdx.x == 0) {
        unsigned* bar = b.bar;
        __builtin_amdgcn_s_waitcnt(0);
        unsigned nloc = b.st[0], nx = b.st[1];
        if (nloc == 0u) { xcd_barrier_complete(bar, b.x, nloc, nx); b.st[0] = nloc; b.st[1] = nx; }
        const unsigned old = xb_add(&bar[XB_XSUB(b.x)], 1u);
        const unsigned gen = old / nloc;
        if (old + 1u == (gen + 1u) * nloc) {
            __builtin_amdgcn_fence(__ATOMIC_RELEASE, "agent");
            asm volatile("s_waitcnt vmcnt(0)" ::: "memory");
            const unsigned og = xb_add(&bar[XB_TOP], 1u);
            const unsigned tg = og / nx;
            if (og + 1u == (tg + 1u) * nx) xb_add(&bar[XB_TOPGEN], 1u);
            else XB_SPIN(xb_ld(&bar[XB_TOPGEN]) == tg, bar);
            __builtin_amdgcn_fence(__ATOMIC_ACQUIRE, "agent");
            xb_add(&bar[XB_XGEN(b.x)], 1u);
            asm volatile("s_waitcnt vmcnt(0)" ::: "memory");
        } else {
            XB_SPIN(xb_ld(&bar[XB_XGEN(b.x)]) == gen, bar);
            __builtin_amdgcn_fence(__ATOMIC_ACQUIRE, "agent");
            asm volatile("s_waitcnt vmcnt(0)" ::: "memory");
        }
    }
    __syncthreads();
}

struct Args { const float* in[21]; float* out; unsigned char* ws; int ph_lo, ph_hi; };
__global__ void __launch_bounds__(NTHREADS, 2) mega_fwd(Args args) {
    extern __shared__ __attribute__((aligned(16))) unsigned char lds_raw[];
    LAS unsigned char* lds = (LAS unsigned char*)lds_raw;
    const int lo = args.ph_lo, hi = args.ph_hi;
    { LAS unsigned* misc0 = (LAS unsigned*)(lds + MISC_OFF); if (threadIdx.x < 64) misc0[threadIdx.x] = 0u; __syncthreads(); }
#ifdef PROBE_REP
    const int hi_x = hi + 1;
#else
    const int hi_x = hi;
#endif
    for (int phx = lo; phx < hi_x; ++phx) {
#ifdef PROBE_REP
        const int ph = phx <= PROBE_REP ? phx : phx - 1; const int rep = (phx == PROBE_REP + 1) ? 1 : 0;
#else
        const int ph = phx; const int rep = 0;
#endif
        int tid = threadIdx.x; asm volatile("" : "+v"(tid));
        typedef const __attribute__((address_space(4))) Args* cargs_t;
        cargs_t ap = (cargs_t)__builtin_amdgcn_kernarg_segment_ptr(); asm volatile("" : "+s"(ap));
#define args (*ap)
        const int lane = tid & 63; const int wave = __builtin_amdgcn_readfirstlane(tid >> 6);
        int bid = blockIdx.x, G = gridDim.x; asm volatile("" : "+s"(bid), "+s"(G));
        const int gw = bid * NWAVES + wave, ngw = G * NWAVES;
        unsigned char* ws = args.ws;
        unsigned* ctl = (unsigned*)(ws + WS_CTL);
        float* RS = (float*)(ws + WS_XN); bf16_t* FB = (bf16_t*)(ws + WS_F); bf16_t* YB = (bf16_t*)(ws + WS_Y); bf16_t* HB = (bf16_t*)(ws + WS_H); bf16_t* PROJ = HB; bf16_t* XB = (bf16_t*)(ws + WS_XB);
#ifdef PROBE_EMPTY
        if (rep) {   } else
#endif
        if (ph == 0) {
            if (bid == 0) { if (tid < 4 * 2 * DEPTH) ctl[64 * tid] = 0u; for (int i = tid; i < XCD_BAR_WORDS; i += NTHREADS) ctl[CW_BAR + i] = 0u; }
            LAS float* scr = (LAS float*)(lds + wave * 16384);
            constexpr int I_GU = (DM / 64) * (DFF / 32), I_D = (DFF / 64) * (DM / 32), I_IN = (DM / 64) * (NIN / 32), I_OUT = (DM / 64) * (DM / 32);
            constexpr int I_LAYER = 4 * I_GU + 2 * I_D + I_IN + I_OUT;
            for (int it = gw; it < DEPTH * I_LAYER; it += ngw) {
                const int l = it / I_LAYER; int rr = it % I_LAYER;
                unsigned char* wl = ws + WS_W + (size_t)l * WL_SIZE;
                const size_t ogu = (size_t)l * DM * DFF, oin = (size_t)l * DM * NIN, oout = (size_t)l * DM * DM;
                if (rr < I_GU) { p0_transpose_item(args.in[2] + ogu, DM, DFF, (bf16_t*)(wl + WL_GU1), 1, scr, rr, lane, args.in[1] + DM * l); continue; } rr -= I_GU;
                if (rr < I_GU) { p0_transpose_item(args.in[3] + ogu, DM, DFF, (bf16_t*)(wl + WL_GU1), 2, scr, rr, lane, args.in[1] + DM * l); continue; } rr -= I_GU;
                if (rr < I_D) { p0_transpose_item(args.in[4] + ogu, DFF, DM, (bf16_t*)(wl + WL_D1), 0, scr, rr, lane, nullptr); continue; } rr -= I_D;
                if (rr < I_IN) { p0_transpose_item(args.in[7] + oin, DM, NIN, (bf16_t*)(wl + WL_IN), 0, scr, rr, lane, args.in[6] + DM * l); continue; } rr -= I_IN;
                if (rr < I_OUT) { p0_transpose_item(args.in[14] + oout, DM, DM, (bf16_t*)(wl + WL_OUT), 0, scr, rr, lane, nullptr); continue; } rr -= I_OUT;
                if (rr < I_GU) { p0_transpose_item(args.in[17] + ogu, DM, DFF, (bf16_t*)(wl + WL_GU2), 1, scr, rr, lane, args.in[16] + DM * l); continue; } rr -= I_GU;
                if (rr < I_GU) { p0_transpose_item(args.in[18] + ogu, DM, DFF, (bf16_t*)(wl + WL_GU2), 2, scr, rr, lane, args.in[16] + DM * l); continue; } rr -= I_GU;
                p0_transpose_item(args.in[19] + ogu, DFF, DM, (bf16_t*)(wl + WL_D2), 0, scr, rr, lane, nullptr);
            }
            norm_rows<false, false, true>(args.in[0], nullptr, 0.f, nullptr, XB, RS, gw, ngw, lane, 0);
            __syncthreads();
        } else {
            const int l = (ph - 1) / 10, s = (ph - 1) % 10;
            unsigned char* wl = ws + WS_W + (size_t)l * WL_SIZE;
            if (s == 0 || s == 7) {
                pg8::Gemm g{XB, (const bf16_t*)(wl + (s == 0 ? WL_GU1 : WL_GU2)), MTOK, NGU, DM};
                pg8::StaticOrder S; S.init(MTOK, NGU, G, bid, ph & 1);
                pg8::EpiSwiGLU E{HB, DFF, RS};
                pg8::gemm_phase<pg8::EpiSwiGLU, pg8::StaticOrder, true, true>(lds, g, S, E, tid);
            } else if (s == 1 || s == 3 || s == 5 || s == 8) {
                const bf16_t* A = (s == 1 || s == 8) ? HB : (s == 3 ? XB : YB);
                const size_t wo = (s == 1) ? WL_D1 : (s == 8) ? WL_D2 : (s == 3) ? WL_IN : WL_OUT;
                const int N = (s == 3) ? NIN : DM, K = (s == 1 || s == 8) ? DFF : DM;
                bf16_t* O = (s == 3) ? PROJ : FB;
                pg8::Gemm g{A, (const bf16_t*)(wl + wo), MTOK, N, K};
                pg8::StaticOrder S; S.init(MTOK, N, G, bid, ph & 1);
                pg8::EpiStore E{O, N, (s == 3) ? 1 : 0, (s == 3) ? RS : nullptr};
                pg8::gemm_phase<pg8::EpiStore, pg8::StaticOrder, true, true>(lds, g, S, E, tid);
            } else if (s == 4) {
                const float lambda_init = 0.8f - 0.6f * __expf(-0.3f * (float)l);
                float lam;
                { const float* q1 = args.in[9] + 32 * l; const float* k1 = args.in[10] + 32 * l; const float* q2 = args.in[11] + 32 * l; const float* k2 = args.in[12] + 32 * l;
                  float v = lane < 32 ? q1[lane] * k1[lane] : q2[lane - 32] * k2[lane - 32];
#pragma unroll
                  for (int o = 1; o < 32; o <<= 1) v += shx(v, lane, o);
                  const float s1 = __int_as_float(__builtin_amdgcn_readlane(__float_as_int(v), 0)), s2 = __int_as_float(__builtin_amdgcn_readlane(__float_as_int(v), 32)); lam = __expf(s1) - __expf(s2) + lambda_init; }
                LAS int* uw = (LAS int*)(lds + att::OFF_UNIT);
                unsigned* qctr = ctl + 64 * 4 * (l + DEPTH * rep);
#define NEXT_UNIT(q, n) if (tid == 0) *uw = (int)atomicAdd(qctr + 64 * (q), 1u); __syncthreads(); const int u = *uw; __syncthreads(); if (u >= (n)) break;
#ifndef NO_B
                for (;;) { NEXT_UNIT(0, 1024)
                    const int qb = 7 - u / 128, w_ = u % 128, b = 31 - w_ / 4, hh = w_ % 4;
                    att::attn_unit<1>(lds, PROJ, YB, b, qb, 1152 + 64 * hh, 1408 + 64 * hh, 1664 + 64 * hh, 384 + 64 * hh, nullptr,
                                      __builtin_amdgcn_exp2f(-2.0f * (float)(hh + 1)) * LOG2E, lam, args.in[13] + 64 * l, 1.0f - lambda_init, tid); }
#endif
#ifndef NO_C
                for (;;) { NEXT_UNIT(1, 1536)
                    const int qb = 7 - u / 192, w_ = u % 192, b = 31 - w_ / 6, hc = w_ % 6;
                    att::attn_unit<2>(lds, PROJ, YB, b, qb, 1920 + 64 * hc, 2304 + 64 * hc, 2688 + 64 * hc, 640 + 64 * hc, nullptr, 0.f, 0.f, nullptr, 0.f, tid); }
#endif
#ifndef NO_A
                for (;;) { NEXT_UNIT(2, 1536)
                    const int b = 31 - u / 48, r_ = u % 48, ha = r_ / 8, qb = r_ % 8;
                    att::attn_unit<0>(lds, PROJ, YB, b, qb, 64 * ha, 384 + 64 * ha, 768 + 64 * ha, 64 * ha, args.in[8] + (size_t)(l * 6 + ha) * 257, 0.f, 0.f, nullptr, 0.f, tid); }
#endif
#undef NEXT_UNIT
            } else {
                const float* gpost = (s == 2) ? args.in[5] + DM * l : (s == 6) ? args.in[15] + DM * l : args.in[20] + DM * l;
                const float wgt = (s == 6) ? 1.0f : 0.5f;
                if (l == 0 && s == 2) norm_rows<true, false, true>(args.in[0], FB, wgt, gpost, XB, RS, gw, ngw, lane, ph & 1);
                else if (l == DEPTH - 1 && s == 9) norm_rows<true, true, false>(XB, FB, wgt, gpost, args.out, nullptr, gw, ngw, lane, ph & 1);
                else norm_rows<true, true, true>(XB, FB, wgt, gpost, XB, RS, gw, ngw, lane, ph & 1);
            }
        }
        if (phx + 1 < hi_x) {
            volatile LAS unsigned* bst = (volatile LAS unsigned*)(lds + MISC_OFF) + 8;
            if (phx == lo) {
                cg::this_grid().sync();
                (void)xcd_barrier_post(ctl + CW_BAR, bst);
            } else { XcdBarrier xb; xb.bar = ctl + CW_BAR; xb.x = xb_xcc_id(); xb.st = bst; xcd_barrier(xb); }
        }
#undef args
    }
}

extern "C" void kernel_launch(void* const* d_in, const int* in_sizes, int n_in, void* d_out, int out_size, void* d_ws, size_t ws_size, hipStream_t stream) {
    static int grid = 0;
    if (grid == 0) {
        if (n_in != 21 || out_size != MTOK * DM || ws_size < WS_END) { fprintf(stderr, "kernel_launch: unexpected shapes (n_in %d, out %d, ws %zu)\n", n_in, out_size, ws_size); grid = -1; return; }
        int dev = 0, cus = 0, per_cu = 0;
        hipGetDevice(&dev); hipDeviceGetAttribute(&cus, hipDeviceAttributeMultiprocessorCount, dev);
        if (hipFuncSetAttribute((const void*)mega_fwd, hipFuncAttributeMaxDynamicSharedMemorySize, LDS_BYTES) != hipSuccess) { fprintf(stderr, "kernel_launch: hipFuncSetAttribute failed\n"); }
        if (hipOccupancyMaxActiveBlocksPerMultiprocessor(&per_cu, (const void*)mega_fwd, NTHREADS, LDS_BYTES) != hipSuccess || per_cu < 1) { fprintf(stderr, "kernel_launch: occupancy query gave %d\n", per_cu); per_cu = 1; }
        (void)hipGetLastError();
        grid = cus * 1;
        fprintf(stderr, "kernel_launch: grid %d (per_cu %d)\n", grid, per_cu);
    }
    if (grid < 0) return;
    Args a{};
    for (int i = 0; i < 21; ++i) a.in[i] = (const float*)d_in[i];
    a.out = (float*)d_out; a.ws = (unsigned char*)d_ws;
#if MULTI_LAUNCH
    for (int ph = 0; ph < NPH; ++ph) { a.ph_lo = ph; a.ph_hi = ph + 1; hipLaunchKernelGGL(mega_fwd, dim3(grid), dim3(NTHREADS), LDS_BYTES, stream, a); }
#else
    a.ph_lo = 0; a.ph_hi = NPH;
    void* kargs[] = {&a};
    hipError_t e = hipLaunchCooperativeKernel((const void*)mega_fwd, dim3(grid), dim3(NTHREADS), kargs, LDS_BYTES, stream);
    if (e != hipSuccess) fprintf(stderr, "kernel_launch: cooperative launch failed: %s (grid %d)\n", hipGetErrorString(e), grid);
#endif
}
```

```cpp
#include <hip/hip_runtime.h>
#include <hip/hip_cooperative_groups.h>
#include <cstdio>
#include <cstdint>
namespace cg = cooperative_groups;
namespace pg8 {
#define PG8_LAS __attribute__((address_space(3)))
typedef unsigned short bf16_t;
typedef short bf16x8 __attribute__((ext_vector_type(8)));
typedef float f32x4 __attribute__((ext_vector_type(4)));
typedef unsigned u32x4 __attribute__((ext_vector_type(4)));
constexpr int BM = 256, BK = 64, HALF = 128, HTB = HALF * BK * 2  , STAGE_BYTES = 8 * HTB, NXCD = 8, WGM = 8;

__host__ __device__ __forceinline__ int lds_byte(int r, int c) { const int st = (r >> 4) * 2 + (c >> 5), rr = r & 15, cc = c & 31, ob = rr * 64 + cc * 2; return st * 1024 + (ob ^ (((ob >> 9) & 1) << 5)); }
__host__ __device__ __forceinline__ void stage_rc(int b, int& R, int& C) { const int st = b / 1024, sb = b % 1024, swz = sb ^ (((sb >> 9) & 1) << 5); R = (st >> 1) * 16 + swz / 64; C = (st & 1) * 32 + (swz % 64) / 2; }
__host__ __device__ __forceinline__ int perm32(int rho) { const int n = rho >> 4, i = rho & 15; return 8 * (i >> 2) + 4 * n + (i & 3); }

struct Unit { int pm, pn; };
struct Gemm { const bf16_t* A; const bf16_t* Bt; int M, N, K; };

struct StaticOrder {
    int nM, nN, nwg, G, c, rev;
    __host__ __device__ void init(int M, int N, int G_, int c_, int rev_ = 0) { nM = M / BM; nN = N / BM; nwg = nM * nN; G = G_; c = c_; rev = rev_; }
    __host__ __device__ bool next(int i, Unit& u) const {
        const long L = (long)i * G + c; if (L >= nwg) return false;
        int wgid = (int)L; { const int q = nwg / NXCD, r = nwg % NXCD, xcd = wgid % NXCD, off = wgid / NXCD; wgid = (xcd < r ? xcd * (q + 1) : r * (q + 1) + (xcd - r) * q) + off; }
        const int nig = WGM * nN, gid = wgid / nig, fm = gid * WGM, gsz = (nM - fm) < WGM ? (nM - fm) : WGM;
        u.pm = fm + ((wgid % nig) % gsz); u.pn = (wgid % nig) / gsz; if (rev) u.pm = nM - 1 - u.pm; return true;
    }
    __device__ __forceinline__ void a_ready(const Unit&) const {}
    __device__ __forceinline__ void done(const Unit&) const {}
};

__device__ __forceinline__ unsigned cvt_pk_bf16(float lo, float hi) { unsigned r; asm volatile("v_cvt_pk_bf16_f32 %0, %1, %2" : "=v"(r) : "v"(lo), "v"(hi)); return r; }
typedef float f32x2 __attribute__((ext_vector_type(2)));
struct EpiStore {
    static constexpr bool PERM = true, AFTER_DRAIN = false;
    bf16_t* O; int ldc; int qscale; const float* rs;
    __device__ __forceinline__ void operator()(const f32x4 (&acc)[2][2][4][2], const Unit& u, int wr, int wc, int fr, int fq) const {
        const int row0 = u.pm * BM + wr * 64 + fr, col0 = u.pn * BM + wc * 32 + 8 * fq;
        float sc[2] = {1.f, 1.f};
        if (qscale) {
#pragma unroll
            for (int bj = 0; bj < 2; ++bj) { const int hx = 2 * u.pn + bj;
                sc[bj] = (hx <= 2 || (hx >= 15 && hx <= 17)) ? 0.125f * 1.4426950408889634f : ((hx == 9 || hx == 10) ? 0.17677669529663687f * 1.4426950408889634f : 1.f); }
        }
#pragma unroll
        for (int ai = 0; ai < 2; ++ai)
#pragma unroll
            for (int m = 0; m < 4; ++m) { bf16_t* rowp = O + (size_t)(row0 + ai * HALF + m * 16) * ldc + col0; const float rv = rs ? rs[row0 + ai * HALF + m * 16] : 1.f;
#pragma unroll
                for (int bj = 0; bj < 2; ++bj) { const float sb = sc[bj] * rv; const f32x4 v0 = acc[ai][bj][m][0] * sb, v1 = acc[ai][bj][m][1] * sb;
                    u32x4 w; w.x = cvt_pk_bf16(v0[0], v0[1]); w.y = cvt_pk_bf16(v0[2], v0[3]); w.z = cvt_pk_bf16(v1[0], v1[1]); w.w = cvt_pk_bf16(v1[2], v1[3]);
                    *(u32x4*)(rowp + bj * HALF) = w; } }
    }
};
struct EpiSwiGLU {
    static constexpr bool PERM = true, AFTER_DRAIN = false;
    bf16_t* O; int ldc; const float* rs;
    static __device__ __forceinline__ float sw(float g, float u) { return g * u * __builtin_amdgcn_rcpf(1.0f + __builtin_amdgcn_exp2f(-1.4426950408889634f * g)); }
    __device__ __forceinline__ void operator()(const f32x4 (&acc)[2][2][4][2], const Unit& u, int wr, int wc, int fr, int fq) const {
        const int row0 = u.pm * BM + wr * 64 + fr;
        bf16_t* tile = O + ((size_t)u.pm * (ldc / BK) + 2 * u.pn + (wc >> 1)) * (BM * BK) + (wc & 1) * 32 + 8 * fq;
#pragma unroll
        for (int ai = 0; ai < 2; ++ai)
#pragma unroll
            for (int m = 0; m < 4; ++m) { bf16_t* rowp = tile + (size_t)(wr * 64 + fr + ai * HALF + m * 16) * BK;
                const float rv = rs[row0 + ai * HALF + m * 16];
                const f32x4 g0 = acc[ai][0][m][0] * rv, g1 = acc[ai][0][m][1] * rv, u0 = acc[ai][1][m][0] * rv, u1 = acc[ai][1][m][1] * rv;
                u32x4 w; w.x = cvt_pk_bf16(sw(g0[0], u0[0]), sw(g0[1], u0[1])); w.y = cvt_pk_bf16(sw(g0[2], u0[2]), sw(g0[3], u0[3]));
                w.z = cvt_pk_bf16(sw(g1[0], u1[0]), sw(g1[1], u1[1])); w.w = cvt_pk_bf16(sw(g1[2], u1[2]), sw(g1[3], u1[3]));
                *(u32x4*)rowp = w; }
    }
};

template <class Epi, class Sched, bool ALIGN_EPI = false, bool SP2 = false, bool ABLK = false>
__device__ __forceinline__ void gemm_phase(PG8_LAS unsigned char* lds, const Gemm g, const Sched& S, const Epi& E, const int tid) {
    const int wid = __builtin_amdgcn_readfirstlane(tid >> 6), lane = tid & 63, wr = wid >> 2, wc = wid & 3, fr = lane & 15, fq = lane >> 4;
    const int K = g.K, nt = K / BK;
    unsigned voffA[2], voffB[2];
#pragma unroll
    for (int i = 0; i < 2; ++i) { int R, C; stage_rc(tid * 16 + i * 8192, R, C); const int Rb = Epi::PERM ? ((R & ~31) + perm32(R & 31)) : R;
        voffA[i] = ABLK ? (unsigned)(R * BK + C) * 2u : (unsigned)(R * K + C) * 2u; voffB[i] = (unsigned)(Rb * K + C) * 2u; }
    const size_t kstepB = (size_t)(BK * 2);
    const size_t hstepB = (size_t)HALF * K * 2;
    const size_t tstepB = 2 * hstepB;
    const size_t kstepA = ABLK ? (size_t)BM * BK * 2 : kstepB, hstepA = ABLK ? (size_t)HALF * BK * 2 : hstepB, tstepA = ABLK ? (size_t)(K / BK) * BM * BK * 2 : tstepB;
    const unsigned ldsw = (unsigned)wid * 1024u;
    const int aoff = lds_byte(wr * 64 + fr, fq * 8), boff = lds_byte(wc * 32 + fr, fq * 8);
#define PG8_SA(b, h) (((b) * 2 + (h)) * HTB)
#define PG8_SB(b, h) ((4 + (b) * 2 + (h)) * HTB)
#define PG8_STAGE(bufoff, gbase, voff) do { _Pragma("unroll") for (int _i = 0; _i < 2; ++_i) \
        __builtin_amdgcn_global_load_lds((const unsigned*)((const char*)(gbase) + (voff)[_i]), (PG8_LAS unsigned*)(lds + (bufoff) + ldsw + _i * 8192), 16, 0, 0); } while (0)
#define PG8_LDA(dst, b, h) do { _Pragma("unroll") for (int m = 0; m < 4; ++m) _Pragma("unroll") for (int k = 0; k < 2; ++k) dst[m][k] = *(const PG8_LAS bf16x8*)(lds + PG8_SA(b, h) + aoff + m * 2048 + k * 1024); } while (0)
#define PG8_LDB(dst, b, h) do { _Pragma("unroll") for (int n = 0; n < 2; ++n) _Pragma("unroll") for (int k = 0; k < 2; ++k) dst[n][k] = *(const PG8_LAS bf16x8*)(lds + PG8_SB(b, h) + boff + n * 2048 + k * 1024); } while (0)
#define PG8_MMA(ai, bj, At, Bt) do { __builtin_amdgcn_s_setprio(1); _Pragma("unroll") for (int m = 0; m < 4; ++m) _Pragma("unroll") for (int n = 0; n < 2; ++n) _Pragma("unroll") for (int k = 0; k < 2; ++k) \
        acc[ai][bj][m][n] = __builtin_amdgcn_mfma_f32_16x16x32_bf16(Bt[n][k], At[m][k], acc[ai][bj][m][n], 0, 0, 0); __builtin_amdgcn_s_setprio(0); } while (0)
#define PG8_WAIT_V(n) asm volatile("s_waitcnt vmcnt(" #n ")" ::: "memory")
#define PG8_WAIT_L(n) asm volatile("s_waitcnt lgkmcnt(" #n ")" ::: "memory")
#define PG8_BAR __builtin_amdgcn_s_barrier()
#define PG8_SCHED __builtin_amdgcn_sched_barrier(0)
    Unit cur, nxt; int ui = 0;
    if (!S.next(0, cur)) return;
    f32x4 acc[2][2][4][2];
#pragma unroll
    for (int a = 0; a < 2; ++a)
#pragma unroll
        for (int b = 0; b < 2; ++b)
#pragma unroll
            for (int m = 0; m < 4; ++m)
#pragma unroll
                for (int n = 0; n < 2; ++n) acc[a][b][m][n] = (f32x4){0.f, 0.f, 0.f, 0.f};
    bf16x8 At[4][2], B0[2][2], B1[2][2];
    const char* cA = (const char*)g.A + (size_t)cur.pm * tstepA; const char* cB = (const char*)g.Bt + (size_t)cur.pn * tstepB;
    S.a_ready(cur);
    if constexpr (SP2) {
        PG8_STAGE(PG8_SB(0, 0), cB, voffB); PG8_STAGE(PG8_SB(0, 1), cB + hstepB, voffB); PG8_STAGE(PG8_SA(0, 0), cA, voffA); PG8_STAGE(PG8_SA(0, 1), cA + hstepA, voffA);
        if (wr == 1) PG8_BAR;
        PG8_WAIT_V(2); PG8_BAR;
        PG8_STAGE(PG8_SB(1, 0), cB + kstepB, voffB); PG8_STAGE(PG8_SA(1, 0), cA + kstepA, voffA); PG8_STAGE(PG8_SB(1, 1), cB + hstepB + kstepB, voffB);
        PG8_WAIT_V(6); PG8_BAR;
    } else {
        PG8_STAGE(PG8_SB(0, 0), cB, voffB); PG8_STAGE(PG8_SA(0, 0), cA, voffA); PG8_STAGE(PG8_SB(0, 1), cB + hstepB, voffB); PG8_STAGE(PG8_SA(0, 1), cA + hstepA, voffA);
        if (wr == 1) PG8_BAR;
        PG8_WAIT_V(4); PG8_BAR;
        PG8_STAGE(PG8_SB(1, 0), cB + kstepB, voffB); PG8_STAGE(PG8_SA(1, 0), cA + kstepA, voffA); PG8_STAGE(PG8_SB(1, 1), cB + hstepB + kstepB, voffB);
        PG8_WAIT_V(6); PG8_BAR;
    }
    for (;;) {
        const bool has_next = S.next(ui + 1, nxt);
        const char* nA = has_next ? (const char*)g.A + (size_t)nxt.pm * tstepA : cA; const char* nB = has_next ? (const char*)g.Bt + (size_t)nxt.pn * tstepB : cB;
        for (int t = 0; t < nt; t += 2) {
            const bool last = (t == nt - 2);
            const char* a1 = cA + (size_t)(t + 1) * kstepA;
            const char* a2 = last ? nA : cA + (size_t)(t + 2) * kstepA; const char* b2 = last ? nB : cB + (size_t)(t + 2) * kstepB;
            const char* a3 = a2 + kstepA; const char* b3 = b2 + kstepB;
            if (last && has_next) S.a_ready(nxt);
            if constexpr (SP2) {
            PG8_LDB(B0, 0, 0); PG8_LDB(B1, 0, 1); PG8_SCHED; PG8_LDA(At, 0, 0); PG8_STAGE(PG8_SA(1, 1), a1 + hstepA, voffA);
            PG8_WAIT_V(8); PG8_WAIT_L(0); PG8_BAR; PG8_MMA(0, 0, At, B0); PG8_MMA(0, 1, At, B1); PG8_BAR; PG8_SCHED;
            PG8_LDA(At, 0, 1); PG8_STAGE(PG8_SB(0, 0), b2, voffB); PG8_STAGE(PG8_SB(0, 1), b2 + hstepB, voffB); PG8_STAGE(PG8_SA(0, 0), a2, voffA);
            PG8_WAIT_V(8); PG8_WAIT_L(0); PG8_BAR; PG8_MMA(1, 0, At, B0); PG8_MMA(1, 1, At, B1); PG8_BAR; PG8_SCHED;
            PG8_LDB(B0, 1, 0); PG8_LDB(B1, 1, 1); PG8_SCHED; PG8_LDA(At, 1, 0); PG8_STAGE(PG8_SA(0, 1), a2 + hstepA, voffA);
            PG8_WAIT_V(8); PG8_WAIT_L(0); PG8_BAR; PG8_MMA(0, 0, At, B0); PG8_MMA(0, 1, At, B1); PG8_BAR; PG8_SCHED;
            PG8_LDA(At, 1, 1); PG8_STAGE(PG8_SB(1, 0), b3, voffB); PG8_STAGE(PG8_SB(1, 1), b3 + hstepB, voffB); PG8_STAGE(PG8_SA(1, 0), a3, voffA);
            PG8_WAIT_V(8); PG8_WAIT_L(0); PG8_BAR; PG8_MMA(1, 0, At, B0); PG8_MMA(1, 1, At, B1); PG8_BAR; PG8_SCHED;
            } else {
            PG8_LDB(B0, 0, 0); PG8_SCHED; PG8_LDA(At, 0, 0); PG8_STAGE(PG8_SA(1, 1), a1 + hstepA, voffA);
            PG8_WAIT_L(8); PG8_BAR; PG8_WAIT_L(0); PG8_MMA(0, 0, At, B0); PG8_BAR; PG8_SCHED;
            PG8_LDB(B1, 0, 1); PG8_STAGE(PG8_SB(0, 0), b2, voffB);
            PG8_BAR; PG8_WAIT_L(0); PG8_MMA(0, 1, At, B1); PG8_BAR;
            PG8_LDA(At, 0, 1); PG8_STAGE(PG8_SA(0, 0), a2, voffA);
            PG8_BAR; PG8_WAIT_L(0); PG8_MMA(1, 0, At, B0); PG8_BAR; PG8_SCHED;
            PG8_STAGE(PG8_SB(0, 1), b2 + hstepB, voffB);
            PG8_WAIT_V(6); PG8_BAR; PG8_MMA(1, 1, At, B1); PG8_BAR;
            PG8_LDB(B0, 1, 0); PG8_SCHED; PG8_LDA(At, 1, 0); PG8_STAGE(PG8_SA(0, 1), a2 + hstepA, voffA);
            PG8_WAIT_L(8); PG8_BAR; PG8_WAIT_L(0); PG8_MMA(0, 0, At, B0); PG8_BAR; PG8_SCHED;
            PG8_LDB(B1, 1, 1); PG8_STAGE(PG8_SB(1, 0), b3, voffB);
            PG8_BAR; PG8_WAIT_L(0); PG8_MMA(0, 1, At, B1); PG8_BAR;
            PG8_LDA(At, 1, 1); PG8_STAGE(PG8_SA(1, 0), a3, voffA);
            PG8_BAR; PG8_WAIT_L(0); PG8_MMA(1, 0, At, B0); PG8_BAR; PG8_SCHED;
            PG8_STAGE(PG8_SB(1, 1), b3 + hstepB, voffB);
            PG8_WAIT_V(6); PG8_BAR; PG8_MMA(1, 1, At, B1); PG8_BAR;
            }
        }
        if constexpr (ALIGN_EPI) { if (wr == 0) PG8_BAR; }
        if constexpr (!Epi::AFTER_DRAIN) { E(acc, cur, wr, wc, fr, fq); S.done(cur); }
        if (!has_next) break;
#pragma unroll
        for (int a = 0; a < 2; ++a)
#pragma unroll
            for (int b = 0; b < 2; ++b)
#pragma unroll
                for (int m = 0; m < 4; ++m)
#pragma unroll
                    for (int n = 0; n < 2; ++n) acc[a][b][m][n] = (f32x4){0.f, 0.f, 0.f, 0.f};
        cur = nxt; cA = nA; cB = nB; ++ui;
        if constexpr (ALIGN_EPI) { if (wr == 1) PG8_BAR; }
    }
    PG8_WAIT_V(0);
    if constexpr (!ALIGN_EPI) { if (wr == 0) PG8_BAR; }
    PG8_BAR;
    if constexpr (Epi::AFTER_DRAIN) { E.fused(acc, cur, wr, wc, fr, fq, lds, wid, lane); S.done(cur); }
#undef PG8_SA
#undef PG8_SB
#undef PG8_STAGE
#undef PG8_LDA
#undef PG8_LDB
#undef PG8_MMA
#undef PG8_WAIT_V
#undef PG8_WAIT_L
#undef PG8_BAR
#undef PG8_SCHED
}
}

#ifndef MULTI_LAUNCH
#define MULTI_LAUNCH 0
#endif
constexpr int BATCH = 32, SEQ = 2048, DM = 1024, MTOK = BATCH * SEQ, DFF = 2816, NIN = 3072, DEPTH = 2, NGU = 2 * DFF;
constexpr float NORM_EPS = 1e-6f;
constexpr float LOG2E = 1.4426950408889634f;
constexpr int NPH = 1 + 10 * DEPTH;
constexpr int NTHREADS = 512, NWAVES = 8;
constexpr size_t MiB = 1u << 20;
constexpr size_t WS_CTL = 0;
constexpr size_t WS_W = 1 * MiB;
constexpr size_t WL_GU1 = 0, WL_D1 = 11 * MiB, WL_IN = WL_D1 + 11 * MiB / 2, WL_OUT = WL_IN + 6 * MiB, WL_GU2 = WL_OUT + 2 * MiB, WL_D2 = WL_GU2 + 11 * MiB, WL_SIZE = WL_D2 + 11 * MiB / 2;
static_assert(WL_SIZE == 41 * MiB, "weights per layer");
constexpr size_t WS_XN = 84 * MiB, WS_F = 212 * MiB, WS_Y = 340 * MiB, WS_H = 468 * MiB, WS_XB = 852 * MiB, WS_END = 980 * MiB;
static_assert(WS_W + DEPTH * WL_SIZE <= WS_XN, "ws map");
constexpr int RING_BYTES = 131072, LDS_BYTES = 147456, MISC_OFF = RING_BYTES;

#define LAS __attribute__((address_space(3)))
typedef unsigned short bf16_t;
typedef unsigned v4u __attribute__((ext_vector_type(4)));
typedef unsigned v2u __attribute__((ext_vector_type(2)));
typedef float f32x4 __attribute__((ext_vector_type(4)));
typedef float f32x2_t __attribute__((ext_vector_type(2)));
typedef __bf16 bf16x2_t __attribute__((ext_vector_type(2)));
typedef short bf16x8 __attribute__((ext_vector_type(8)));
typedef short s16x4 __attribute__((ext_vector_type(4)));
typedef float f32x16 __attribute__((ext_vector_type(16)));
#define LDS_WAIT() asm volatile("s_waitcnt lgkmcnt(0)" ::: "memory")

__device__ __forceinline__ unsigned pk2(float lo, float hi) { f32x2_t v = {lo, hi}; bf16x2_t b = __builtin_convertvector(v, bf16x2_t); return __builtin_bit_cast(unsigned, b); }
__device__ __forceinline__ float bf_lo(unsigned w) { return __uint_as_float(w << 16); }
__device__ __forceinline__ float bf_hi(unsigned w) { return __uint_as_float(w & 0xffff0000u); }
__device__ __forceinline__ float shx(float v, int lane, int o) { return __int_as_float(__builtin_amdgcn_ds_bpermute((lane ^ o) << 2, __float_as_int(v))); }
__device__ __forceinline__ float wave_sum(float v, int lane) {
#pragma unroll
    for (int o = 1; o < 64; o <<= 1) v += shx(v, lane, o);
    return v;
}

__device__ __forceinline__ void p0_transpose_item(const float* W, int K, int N, bf16_t* WT, int gu, LAS float* scr, int item, int lane, const float* gk) {
    const int nblk = N / 32, kb = item / nblk, nb = item % nblk, k0 = 64 * kb, n0 = 32 * nb;
#pragma unroll 8
    for (int i = 0; i < 32; ++i) { const int kk = 2 * i + (lane >> 5); const float gv = gk ? gk[k0 + kk] : 1.f; scr[kk * 33 + (lane & 31)] = W[(size_t)(k0 + kk) * N + n0 + (lane & 31)] * gv; }
    LDS_WAIT(); asm volatile("" ::: "memory");
    const int c = lane & 7;
    const int r0 = gu ? (256 * (n0 >> 7) + (n0 & 127) + (gu == 2 ? 128 : 0)) : n0;
#pragma unroll
    for (int j = 0; j < 4; ++j) { const int n = (lane >> 3) + 8 * j; const LAS float* s = scr + (8 * c) * 33 + n;
        v4u o; o.x = pk2(s[0 * 33], s[1 * 33]); o.y = pk2(s[2 * 33], s[3 * 33]); o.z = pk2(s[4 * 33], s[5 * 33]); o.w = pk2(s[6 * 33], s[7 * 33]);
        *(v4u*)(WT + (size_t)(r0 + n) * K + k0 + 8 * c) = o; }
    LDS_WAIT(); asm volatile("" ::: "memory");
}

__device__ __forceinline__ float dpp_x(float v, const int ctrl) { return v; }
#define DPP_ADD(v, ctrl) (v) += __int_as_float(__builtin_amdgcn_update_dpp(0, __float_as_int(v), (ctrl), 0xf, 0xf, true))
__device__ __forceinline__ float wave_sum_fast(float v) {
    DPP_ADD(v, 0xB1);
    DPP_ADD(v, 0x4E);
    DPP_ADD(v, 0x141);
    DPP_ADD(v, 0x140);
    v += __int_as_float(__builtin_amdgcn_ds_swizzle(__float_as_int(v), 0x401F));
    auto rr = __builtin_amdgcn_permlane32_swap(__float_as_uint(v), __float_as_uint(v), false, false);
    return __uint_as_float(rr[0]) + __uint_as_float(rr[1]);
}
template <bool HAS_F, bool XS16>
struct RawRows { static constexpr int NR = XS16 ? 4 : 2;
    f32x4 xf[XS16 ? 1 : NR][XS16 ? 1 : 4]; v2u xh[XS16 ? NR : 1][XS16 ? 4 : 1]; v2u fh[HAS_F ? NR : 1][HAS_F ? 4 : 1]; };
template <bool HAS_F, bool XS16>
__device__ __forceinline__ void norm_load(RawRows<HAS_F, XS16>& R, const void* xsrc_, const bf16_t* F, int row, int lane) {
    constexpr int NR = RawRows<HAS_F, XS16>::NR;
#pragma unroll
    for (int q = 0; q < NR; ++q) {
        if (XS16) { const v2u* xr = (const v2u*)((const bf16_t*)xsrc_ + (size_t)(row + q) * DM) + lane;
#pragma unroll
            for (int j = 0; j < 4; ++j) R.xh[XS16 ? q : 0][XS16 ? j : 0] = xr[64 * j]; }
        else { const f32x4* xr = (const f32x4*)((const float*)xsrc_ + (size_t)(row + q) * DM) + lane;
#pragma unroll
            for (int j = 0; j < 4; ++j) R.xf[XS16 ? 0 : q][XS16 ? 0 : j] = xr[64 * j]; }
        if (HAS_F) { const v2u* fp = (const v2u*)(F + (size_t)(row + q) * DM) + lane;
#pragma unroll
            for (int j = 0; j < 4; ++j) R.fh[HAS_F ? q : 0][HAS_F ? j : 0] = fp[64 * j]; }
    }
}
template <bool HAS_F, bool XS16, bool XD16>
__device__ __forceinline__ void norm_rows(const void* xsrc_, const bf16_t* F, float w, const float* gpost, void* xdst_, float* RS, int gw, int ngw, int lane, int rev) {
    constexpr int NR = RawRows<HAS_F, XS16>::NR;
    f32x4 gp[4];
#pragma unroll
    for (int j = 0; j < 4; ++j) gp[j] = HAS_F ? *((const f32x4*)gpost + lane + 64 * j) : (f32x4){0.f, 0.f, 0.f, 0.f};
    const int step = NR * ngw;
    RawRows<HAS_F, XS16> cur;
#define ROWMAP(r_) (rev ? (MTOK - NR - (r_)) : (r_))
    norm_load<HAS_F, XS16>(cur, xsrc_, F, ROWMAP(NR * gw), lane);
    for (int row_ = NR * gw; row_ < MTOK; row_ += step) {
        RawRows<HAS_F, XS16> nxt; const bool hn = row_ + step < MTOK; const int row = ROWMAP(row_);
        if (hn) norm_load<HAS_F, XS16>(nxt, xsrc_, F, ROWMAP(row_ + step), lane);
        f32x4 v[NR][4];
#pragma unroll
        for (int q = 0; q < NR; ++q)
#pragma unroll
            for (int j = 0; j < 4; ++j) { if (XS16) { const v2u t = cur.xh[XS16 ? q : 0][XS16 ? j : 0]; v[q][j] = (f32x4){bf_lo(t.x), bf_hi(t.x), bf_lo(t.y), bf_hi(t.y)}; } else v[q][j] = cur.xf[XS16 ? 0 : q][XS16 ? 0 : j]; }
        if (HAS_F) {
            float ss[NR];
#pragma unroll
            for (int q = 0; q < NR; ++q) { ss[q] = 0.f;
#pragma unroll
                for (int j = 0; j < 4; ++j) { const v2u t = cur.fh[HAS_F ? q : 0][HAS_F ? j : 0]; const f32x4 f = (f32x4){bf_lo(t.x), bf_hi(t.x), bf_lo(t.y), bf_hi(t.y)}; ss[q] += (f.x * f.x + f.y * f.y) + (f.z * f.z + f.w * f.w); } }
#pragma unroll
            for (int q = 0; q < NR; ++q) ss[q] = wave_sum_fast(ss[q]);
#pragma unroll
            for (int q = 0; q < NR; ++q) { const float rs = w * __builtin_amdgcn_rsqf(ss[q] * (1.f / DM) + NORM_EPS);
#pragma unroll
                for (int j = 0; j < 4; ++j) { const v2u t = cur.fh[HAS_F ? q : 0][HAS_F ? j : 0]; const f32x4 f = (f32x4){bf_lo(t.x), bf_hi(t.x), bf_lo(t.y), bf_hi(t.y)}; v[q][j] = v[q][j] + (f * rs) * gp[j]; } }
        }
        if (XD16) {
#pragma unroll
            for (int q = 0; q < NR; ++q) { v2u* xo = (v2u*)((bf16_t*)xdst_ + (size_t)(row + q) * DM) + lane;
#pragma unroll
                for (int j = 0; j < 4; ++j) { v2u t; t.x = pk2(v[q][j].x, v[q][j].y); t.y = pk2(v[q][j].z, v[q][j].w); xo[64 * j] = t;
                    v[q][j] = (f32x4){bf_lo(t.x), bf_hi(t.x), bf_lo(t.y), bf_hi(t.y)}; } }
        } else {
#pragma unroll
            for (int q = 0; q < NR; ++q) { f32x4* xo = (f32x4*)((float*)xdst_ + (size_t)(row + q) * DM) + lane;
#pragma unroll
                for (int j = 0; j < 4; ++j) xo[64 * j] = v[q][j]; }
        }
        if (RS) {
            float s2[NR];
#pragma unroll
            for (int q = 0; q < NR; ++q) { s2[q] = 0.f;
#pragma unroll
                for (int j = 0; j < 4; ++j) s2[q] += (v[q][j].x * v[q][j].x + v[q][j].y * v[q][j].y) + (v[q][j].z * v[q][j].z + v[q][j].w * v[q][j].w); }
#pragma unroll
            for (int q = 0; q < NR; ++q) s2[q] = wave_sum_fast(s2[q]);
            float mine = s2[0];
#pragma unroll
            for (int q = 1; q < NR; ++q) mine = (lane == q) ? s2[q] : mine;
            if (lane < NR) RS[row + lane] = __builtin_amdgcn_rsqf(mine * (1.f / DM) + NORM_EPS);
        }
        if (hn) cur = nxt;
    }
#undef ROWMAP
}

namespace att {
constexpr int KROW = 144, TILEB = 64 * KROW;
constexpr int OFF_K = 0, OFF_V = 2 * TILEB, OFF_BIAS = 4 * TILEB, OFF_UNIT = OFF_BIAS + 1040;
#define MFMA32(a, b, c) __builtin_amdgcn_mfma_f32_32x32x16_bf16((a), (b), (c), 0, 0, 0)
typedef short v4i16_t __attribute__((ext_vector_type(4)));
__device__ __forceinline__ s16x4 vtr(LAS const unsigned char* p) { return __builtin_bit_cast(s16x4, __builtin_amdgcn_ds_read_tr16_b64_v4i16((LAS v4i16_t*)p)); }
__device__ __forceinline__ void xswap(float v, float& v0, float& v1) { auto rr = __builtin_amdgcn_permlane32_swap(__float_as_uint(v), __float_as_uint(v), false, false); v0 = __uint_as_float(rr[0]); v1 = __uint_as_float(rr[1]); }
__device__ __forceinline__ float xmax(float v) { float a, b; xswap(v, a, b); return fmaxf(a, b); }
__device__ __forceinline__ float xsum(float v) { float a, b; xswap(v, a, b); return a + b; }
__device__ __forceinline__ bf16x8 packp(const f32x16& p, int s) {
    v4u w; w.x = pk2(p[8 * s], p[8 * s + 1]); w.y = pk2(p[8 * s + 2], p[8 * s + 3]); w.z = pk2(p[8 * s + 4], p[8 * s + 5]); w.w = pk2(p[8 * s + 6], p[8 * s + 7]);
    return __builtin_bit_cast(bf16x8, w);
}
template <int D0, int D1>
__device__ __forceinline__ f32x16 qk(LAS const unsigned char* kt, int sub, const bf16x8* qf, int r, int h) {
    f32x16 acc = {};
    LAS const unsigned char* kp = kt + (32 * sub + r) * KROW + 16 * h;
#pragma unroll
    for (int d0 = D0; d0 < D1; ++d0) { const bf16x8 kf = *(LAS const bf16x8*)(kp + 32 * d0); acc = MFMA32(kf, qf[d0], acc); }
    return acc;
}
__device__ __forceinline__ void pv(f32x16 (&O)[2], LAS const unsigned char* vt, int sub, const f32x16& p, int lane) {
    const int h = lane >> 5, i16 = lane & 15, q = i16 >> 2, pp = i16 & 3, blk = (lane >> 4) & 1;
    LAS const unsigned char* vp = vt + (32 * sub + 4 * h + q) * KROW + 32 * blk + 8 * pp;
#pragma unroll
    for (int s = 0; s < 2; ++s) {
        const bf16x8 pf = packp(p, s);
#pragma unroll
        for (int dblk = 0; dblk < 2; ++dblk) {
            const s16x4 lo = vtr(vp + (16 * s) * KROW + 64 * dblk), hi = vtr(vp + (16 * s + 8) * KROW + 64 * dblk);
            const bf16x8 vf = __builtin_shufflevector(lo, hi, 0, 1, 2, 3, 4, 5, 6, 7);
            O[dblk] = MFMA32(vf, pf, O[dblk]);
        }
    }
}
__device__ __forceinline__ void osm(f32x16& p0, f32x16& p1, float lbase, float& m, float& l, f32x16 (&O)[2]) {
#define MX2(a, b) __builtin_amdgcn_fmed3f((a), (b), 3.0e38f)
    float ra = MX2(p0[0], p1[0]), rb = MX2(p0[1], p1[1]);
#pragma unroll
    for (int i = 2; i < 16; i += 2) { ra = MX2(ra, MX2(p0[i], p1[i])); rb = MX2(rb, MX2(p0[i + 1], p1[i + 1])); }
    float rm = MX2(ra, rb);
#undef MX2
    rm = xmax(rm + lbase);
    if (__any(rm > m + 8.0f)) {
        const float mn = fmaxf(m, rm), alpha = __builtin_amdgcn_exp2f(m - mn); m = mn; l *= alpha;
#pragma unroll
        for (int i = 0; i < 16; ++i) { O[0][i] *= alpha; O[1][i] *= alpha; }
    }
    const float mm = m - lbase; float s = 0.f;
#pragma unroll
    for (int i = 0; i < 16; ++i) { p0[i] = __builtin_amdgcn_exp2f(p0[i] - mm); p1[i] = __builtin_amdgcn_exp2f(p1[i] - mm); s += p0[i] + p1[i]; }
    l += s;
}

template <int MODE>
__device__ __forceinline__ void attn_unit(LAS unsigned char* lds, const bf16_t* PROJ, bf16_t* Y, int b, int qb, int colQ, int colK, int colV, int colO,
                                          const float* relb, float slope2, float lam, const float* subg, float outscale, const int tid) {
    const int lane = tid & 63, r = lane & 31, h = lane >> 5; const int w = __builtin_amdgcn_readfirstlane(tid >> 6);
    const int tq0 = qb * 256 + 32 * w, t = tq0 + r;
    const size_t rowb = (size_t)b * SEQ;
    LAS unsigned char* Kb = lds + OFF_K; LAS unsigned char* Vb = lds + OFF_V; LAS float* biasl = (LAS float*)(lds + OFF_BIAS);
    const int c0 = 4 * qb;
    const int kt_lo = (MODE == 0) ? (c0 - 8 > 0 ? c0 - 8 : 0) : 0, kt_hi = c0 + 3, nt = kt_hi - kt_lo + 1;
    const int cw = c0 + (w >> 1);
    const int lrow = tid >> 3, lch = tid & 7;
    const bf16_t* kg = PROJ + (rowb + lrow) * NIN + colK + lch * 8;
    const bf16_t* vg = PROJ + (rowb + lrow) * NIN + colV + lch * 8;
    const int lofs = lrow * KROW + lch * 16;
#define KT(i) ((MODE == 2) ? (kt_hi - (i)) : (kt_lo + (i)))
    v4u kr = *(const v4u*)(kg + (size_t)KT(0) * 64 * NIN), vr = *(const v4u*)(vg + (size_t)KT(0) * 64 * NIN);
    if (MODE == 0) { if (tid < 257) biasl[tid] = relb[tid] * LOG2E; }
    bf16x8 qf[4];
    { const bf16_t* qp = PROJ + (rowb + t) * NIN + colQ + 8 * h;
#pragma unroll
      for (int d0 = 0; d0 < 4; ++d0) qf[d0] = *(const bf16x8*)(qp + 16 * d0); }
    *(LAS v4u*)(Kb + lofs) = kr; *(LAS v4u*)(Vb + lofs) = vr;
    __syncthreads();
    f32x16 O0[2] = {}, O1[2] = {};
    float m0 = -1e30f, l0 = 0.f, m1 = -1e30f, l1 = 0.f, Prun = 1.f;
    if (MODE == 1) asm volatile("" : "+v"(slope2));
    for (int i = 0; i < nt; ++i) {
        const int kt = KT(i), buf = i & 1;
        if (i + 1 < nt) { kr = *(const v4u*)(kg + (size_t)KT(i + 1) * 64 * NIN); vr = *(const v4u*)(vg + (size_t)KT(i + 1) * 64 * NIN); }
        LAS const unsigned char* ktile = Kb + buf * TILEB; LAS const unsigned char* vtile = Vb + buf * TILEB;
        int wdone = 0;
        if (MODE == 0) {
            if (kt >= cw - 8 && kt <= cw) {
                f32x16 p0 = qk<0, 4>(ktile, 0, qf, r, h), p1 = qk<0, 4>(ktile, 1, qf, r, h);
                float lb = 0.f;
                if (kt <= cw - 3) lb = biasl[256];
                else { const int d0 = t - (kt * 64 + 4 * h) + 128;
#pragma unroll
                    for (int j = 0; j < 16; ++j) { const int ko = (j & 3) + 8 * (j >> 2); int i0 = d0 - ko, i1 = d0 - ko - 32;
                        i0 = i0 < 0 ? 0 : (i0 > 256 ? 256 : i0); i1 = i1 < 0 ? 0 : (i1 > 256 ? 256 : i1);
                        p0[j] += biasl[i0]; p1[j] += biasl[i1]; }
                }
                osm(p0, p1, lb, m0, l0, O0);
                pv(O0, vtile, 0, p0, lane); pv(O0, vtile, 1, p1, lane);
            }
        } else if (MODE == 1) {
            if (kt <= cw) {
                const float dist0 = (float)(t - (kt * 64 + 4 * h));
                const bool diag = (kt == cw);
                const float lb = diag ? 0.f : -slope2 * dist0;
                { f32x16 p0 = qk<0, 2>(ktile, 0, qf, r, h), p1 = qk<0, 2>(ktile, 1, qf, r, h);
                  if (diag) {
#pragma unroll
                      for (int j = 0; j < 16; ++j) { const float ko = (float)((j & 3) + 8 * (j >> 2)); p0[j] -= slope2 * fabsf(dist0 - ko); p1[j] -= slope2 * fabsf(dist0 - ko - 32.f); }
                  } else {
#pragma unroll
                      for (int j = 0; j < 16; ++j) { const float ko = (float)((j & 3) + 8 * (j >> 2)); p0[j] = fmaf(slope2, ko, p0[j]); p1[j] = fmaf(slope2, ko + 32.f, p1[j]); }
                  }
                  osm(p0, p1, lb, m0, l0, O0); pv(O0, vtile, 0, p0, lane); pv(O0, vtile, 1, p1, lane); }
                { float dist1 = dist0; int vo = buf * TILEB; asm volatile("" : "+v"(dist1), "+s"(vo));
                  LAS const unsigned char* vtile1 = Vb + vo;
                  f32x16 p0 = qk<2, 4>(ktile, 0, qf, r, h), p1 = qk<2, 4>(ktile, 1, qf, r, h);
                  if (diag) {
#pragma unroll
                      for (int j = 0; j < 16; ++j) { const float ko = (float)((j & 3) + 8 * (j >> 2)); p0[j] -= slope2 * fabsf(dist1 - ko); p1[j] -= slope2 * fabsf(dist1 - ko - 32.f); }
                  } else {
#pragma unroll
                      for (int j = 0; j < 16; ++j) { const float ko = (float)((j & 3) + 8 * (j >> 2)); p0[j] = fmaf(slope2, ko, p0[j]); p1[j] = fmaf(slope2, ko + 32.f, p1[j]); }
                  }
                  osm(p0, p1, lb, m1, l1, O1); pv(O1, vtile1, 0, p0, lane); pv(O1, vtile1, 1, p1, lane); }
            }
        } else {
            if (!__all(Prun < 1e-30f)) {
#pragma unroll
                for (int sub = 1; sub >= 0; --sub) {
                    const int ks = kt * 64 + 32 * sub;
                    if (ks <= tq0) {
                        f32x16 a = qk<0, 4>(ktile, sub, qf, r, h); f32x16 om;
#pragma unroll
                        for (int j = 0; j < 16; ++j) { const float e = __builtin_amdgcn_exp2f(-a[j]), bt = __builtin_amdgcn_rcpf(1.0f + e); a[j] = bt; om[j] = 1.0f - bt; }
                        if (ks == tq0) {
                            const int thr = r - 4 * h;
#pragma unroll
                            for (int j = 0; j < 16; ++j) { const bool valid = ((j & 3) + 8 * (j >> 2)) < thr; om[j] = valid ? om[j] : 1.f; a[j] = valid ? a[j] : 0.f; }
                        }
                        float after = 1.f, carry[4];
#pragma unroll
                        for (int g = 3; g >= 0; --g) { const float G = (om[4 * g] * om[4 * g + 1]) * (om[4 * g + 2] * om[4 * g + 3]); float G0, G1; xswap(G, G0, G1);
                            carry[g] = (Prun * after) * (h == 0 ? G1 : 1.f); after *= G0 * G1; }
                        Prun *= after;
#pragma unroll
                        for (int g = 0; g < 4; ++g) { const float s3 = carry[g], s2 = s3 * om[4 * g + 3], s1 = s2 * om[4 * g + 2], s0 = s1 * om[4 * g + 1];
                            a[4 * g + 3] *= s3; a[4 * g + 2] *= s2; a[4 * g + 1] *= s1; a[4 * g] *= s0; }
                        pv(O0, vtile, sub, a, lane);
                    }
                }
            }
            wdone = __all(Prun < 1e-30f);
        }
        if (i + 1 < nt) { const int nb = (i + 1) & 1; *(LAS v4u*)(Kb + nb * TILEB + lofs) = kr; *(LAS v4u*)(Vb + nb * TILEB + lofs) = vr; }
        if (MODE == 2) { if (__syncthreads_and(wdone)) break; }
        else __syncthreads();
    }
#undef KT
    bf16_t* yp = Y + (rowb + t) * DM + colO + 4 * h;
    if (MODE == 0) { const float il = __builtin_amdgcn_rcpf(xsum(l0));
#pragma unroll
        for (int j = 0; j < 16; ++j) { O0[0][j] *= il; O0[1][j] *= il; }
    } else if (MODE == 1) {
        const float i0 = __builtin_amdgcn_rcpf(xsum(l0)), i1 = lam * __builtin_amdgcn_rcpf(xsum(l1)); float ss = 0.f;
#pragma unroll
        for (int j = 0; j < 16; ++j) { O0[0][j] = O0[0][j] * i0 - O1[0][j] * i1; O0[1][j] = O0[1][j] * i0 - O1[1][j] * i1; ss += O0[0][j] * O0[0][j] + O0[1][j] * O0[1][j]; }
        const float rs = __builtin_amdgcn_rsqf(xsum(ss) * (1.f / 64.f) + NORM_EPS) * outscale;
#pragma unroll
        for (int dblk = 0; dblk < 2; ++dblk)
#pragma unroll
            for (int g = 0; g < 4; ++g) { const f32x4 gg = *(const f32x4*)(subg + 32 * dblk + 8 * g + 4 * h);
                O0[dblk][4 * g] *= rs * gg.x; O0[dblk][4 * g + 1] *= rs * gg.y; O0[dblk][4 * g + 2] *= rs * gg.z; O0[dblk][4 * g + 3] *= rs * gg.w; }
    }
#pragma unroll
    for (int dblk = 0; dblk < 2; ++dblk)
#pragma unroll
        for (int g = 0; g < 4; ++g) { v2u o; o.x = pk2(O0[dblk][4 * g], O0[dblk][4 * g + 1]); o.y = pk2(O0[dblk][4 * g + 2], O0[dblk][4 * g + 3]);
            *(v2u*)(yp + 32 * dblk + 8 * g) = o; }
}
}

constexpr int CW_BAR = 4096;
#define XB_TMO      128
#define XB_XCNT(j)  (256  + 64 * (j))
#define XB_XSUB(j)  (1280 + 64 * (j))
#define XB_XGEN(j)  (2304 + 64 * (j))
#define XB_TOP      3328
#define XB_TOPGEN   3392
#define XCD_BAR_WORDS 3456
#define XB_SPIN_CAP (1u << 18)

__device__ __forceinline__ unsigned xb_ld(unsigned* p)              { return __hip_atomic_load(p, __ATOMIC_RELAXED, __HIP_MEMORY_SCOPE_AGENT); }
__device__ __forceinline__ unsigned xb_add(unsigned* p, unsigned v) { return __hip_atomic_fetch_add(p, v, __ATOMIC_RELAXED, __HIP_MEMORY_SCOPE_AGENT); }
__device__ __forceinline__ unsigned xb_xcc_id() { return (unsigned)__builtin_amdgcn_s_getreg((3 << 11) | 20) & 0xFu; }
#define XB_SPIN(cond, bar) do { unsigned _sp = 0; while (cond) { __builtin_amdgcn_s_sleep(1); \
    if ((++_sp & 255u) == 0u) { if (xb_ld(&(bar)[XB_TMO])) break; if (_sp > XB_SPIN_CAP) { atomicAdd(&(bar)[XB_TMO], 1u); break; } } } } while (0)

struct XcdBarrier {
    unsigned* bar; unsigned x;
    volatile LAS unsigned* st;
};

__device__ __forceinline__ XcdBarrier xcd_barrier_post(unsigned* bar, volatile LAS unsigned* st) {
    XcdBarrier b; b.bar = bar; b.x = xb_xcc_id(); b.st = st;
    if (threadIdx.x == 0) (void)xb_add(&bar[XB_XCNT(b.x)], 1u);
    return b;
}
__device__ __forceinline__ void xcd_barrier_complete(unsigned* bar, unsigned x, unsigned& nloc, unsigned& nx) {
    const unsigned G = gridDim.x * gridDim.y * gridDim.z;
    unsigned sum, cnt, mine, sp = 0u;
    for (;;) {
        sum = 0u; cnt = 0u; mine = 0u;
#pragma unroll
        for (unsigned j = 0; j < 16; ++j) { const unsigned c = xb_ld(&bar[XB_XCNT(j)]); sum += c; cnt += (c > 0u) ? 1u : 0u; mine = (j == x) ? c : mine; }
        if (sum == G) break;
        __builtin_amdgcn_s_sleep(1);
        if ((++sp & 255u) == 0u) { if (xb_ld(&bar[XB_TMO])) break; if (sp > XB_SPIN_CAP) { atomicAdd(&bar[XB_TMO], 1u); break; } }
    }
    nloc = mine > 0u ? mine : 1u; nx = cnt > 0u ? cnt : 1u;
}

__device__ __forceinline__ void xcd_barrier(const XcdBarrier& b) {
    asm volatile("s_waitcnt vmcnt(0)" ::: "memory");
    __syncthreads();
    if (threadIdx.x == 0) {
        unsigned* bar = b.bar;
        __builtin_amdgcn_s_waitcnt(0);
        unsigned nloc = b.st[0], nx = b.st[1];
        if (nloc == 0u) { xcd_barrier_complete(bar, b.x, nloc, nx); b.st[0] = nloc; b.st[1] = nx; }
        const unsigned old = xb_add(&bar[XB_XSUB(b.x)], 1u);
        const unsigned gen = old / nloc;
        if (old + 1u == (gen + 1u) * nloc) {
            __builtin_amdgcn_fence(__ATOMIC_RELEASE, "agent");
            asm volatile("s_waitcnt vmcnt(0)" ::: "memory");
            const unsigned og = xb_add(&bar[XB_TOP], 1u);
            const unsigned tg = og / nx;
            if (og + 1u == (tg + 1u) * nx) xb_add(&bar[XB_TOPGEN], 1u);
            else XB_SPIN(xb_ld(&bar[XB_TOPGEN]) == tg, bar);
            __builtin_amdgcn_fence(__ATOMIC_ACQUIRE, "agent");
            xb_add(&bar[XB_XGEN(b.x)], 1u);
            asm volatile("s_waitcnt vmcnt(0)" ::: "memory");
        } else {
            XB_SPIN(xb_ld(&bar[XB_XGEN(b.x)]) == gen, bar);
            __builtin_amdgcn_fence(__ATOMIC_ACQUIRE, "agent");
            asm volatile("s_waitcnt vmcnt(0)" ::: "memory");
        }
    }
    __syncthreads();
}

struct Args { const float* in[21]; float* out; unsigned char* ws; int ph_lo, ph_hi; };
__global__ void __launch_bounds__(NTHREADS, 2) mega_fwd(Args args) {
    extern __shared__ __attribute__((aligned(16))) unsigned char lds_raw[];
    LAS unsigned char* lds = (LAS unsigned char*)lds_raw;
    const int lo = args.ph_lo, hi = args.ph_hi;
    { LAS unsigned* misc0 = (LAS unsigned*)(lds + MISC_OFF); if (threadIdx.x < 64) misc0[threadIdx.x] = 0u; __syncthreads(); }
#ifdef PROBE_REP
    const int hi_x = hi + 1;
#else
    const int hi_x = hi;
#endif
    for (int phx = lo; phx < hi_x; ++phx) {
#ifdef PROBE_REP
        const int ph = phx <= PROBE_REP ? phx : phx - 1; const int rep = (phx == PROBE_REP + 1) ? 1 : 0;
#else
        const int ph = phx; const int rep = 0;
#endif
        int tid = threadIdx.x; asm volatile("" : "+v"(tid));
        typedef const __attribute__((address_space(4))) Args* cargs_t;
        cargs_t ap = (cargs_t)__builtin_amdgcn_kernarg_segment_ptr(); asm volatile("" : "+s"(ap));
#define args (*ap)
        const int lane = tid & 63; const int wave = __builtin_amdgcn_readfirstlane(tid >> 6);
        int bid = blockIdx.x, G = gridDim.x; asm volatile("" : "+s"(bid), "+s"(G));
        const int gw = bid * NWAVES + wave, ngw = G * NWAVES;
        unsigned char* ws = args.ws;
        unsigned* ctl = (unsigned*)(ws + WS_CTL);
        float* RS = (float*)(ws + WS_XN); bf16_t* FB = (bf16_t*)(ws + WS_F); bf16_t* YB = (bf16_t*)(ws + WS_Y); bf16_t* HB = (bf16_t*)(ws + WS_H); bf16_t* PROJ = HB; bf16_t* XB = (bf16_t*)(ws + WS_XB);
#ifdef PROBE_EMPTY
        if (rep) {   } else
#endif
        if (ph == 0) {
            if (bid == 0) { if (tid < 4 * 2 * DEPTH) ctl[64 * tid] = 0u; for (int i = tid; i < XCD_BAR_WORDS; i += NTHREADS) ctl[CW_BAR + i] = 0u; }
            LAS float* scr = (LAS float*)(lds + wave * 16384);
            constexpr int I_GU = (DM / 64) * (DFF / 32), I_D = (DFF / 64) * (DM / 32), I_IN = (DM / 64) * (NIN / 32), I_OUT = (DM / 64) * (DM / 32);
            constexpr int I_LAYER = 4 * I_GU + 2 * I_D + I_IN + I_OUT;
            for (int it = gw; it < DEPTH * I_LAYER; it += ngw) {
                const int l = it / I_LAYER; int rr = it % I_LAYER;
                unsigned char* wl = ws + WS_W + (size_t)l * WL_SIZE;
                const size_t ogu = (size_t)l * DM * DFF, oin = (size_t)l * DM * NIN, oout = (size_t)l * DM * DM;
                if (rr < I_GU) { p0_transpose_item(args.in[2] + ogu, DM, DFF, (bf16_t*)(wl + WL_GU1), 1, scr, rr, lane, args.in[1] + DM * l); continue; } rr -= I_GU;
                if (rr < I_GU) { p0_transpose_item(args.in[3] + ogu, DM, DFF, (bf16_t*)(wl + WL_GU1), 2, scr, rr, lane, args.in[1] + DM * l); continue; } rr -= I_GU;
                if (rr < I_D) { p0_transpose_item(args.in[4] + ogu, DFF, DM, (bf16_t*)(wl + WL_D1), 0, scr, rr, lane, nullptr); continue; } rr -= I_D;
                if (rr < I_IN) { p0_transpose_item(args.in[7] + oin, DM, NIN, (bf16_t*)(wl + WL_IN), 0, scr, rr, lane, args.in[6] + DM * l); continue; } rr -= I_IN;
                if (rr < I_OUT) { p0_transpose_item(args.in[14] + oout, DM, DM, (bf16_t*)(wl + WL_OUT), 0, scr, rr, lane, nullptr); continue; } rr -= I_OUT;
                if (rr < I_GU) { p0_transpose_item(args.in[17] + ogu, DM, DFF, (bf16_t*)(wl + WL_GU2), 1, scr, rr, lane, args.in[16] + DM * l); continue; } rr -= I_GU;
                if (rr < I_GU) { p0_transpose_item(args.in[18] + ogu, DM, DFF, (bf16_t*)(wl + WL_GU2), 2, scr, rr, lane, args.in[16] + DM * l); continue; } rr -= I_GU;
                p0_transpose_item(args.in[19] + ogu, DFF, DM, (bf16_t*)(wl + WL_D2), 0, scr, rr, lane, nullptr);
            }
            norm_rows<false, false, true>(args.in[0], nullptr, 0.f, nullptr, XB, RS, gw, ngw, lane, 0);
            __syncthreads();
        } else {
            const int l = (ph - 1) / 10, s = (ph - 1) % 10;
            unsigned char* wl = ws + WS_W + (size_t)l * WL_SIZE;
            if (s == 0 || s == 7) {
                pg8::Gemm g{XB, (const bf16_t*)(wl + (s == 0 ? WL_GU1 : WL_GU2)), MTOK, NGU, DM};
                pg8::StaticOrder S; S.init(MTOK, NGU, G, bid, ph & 1);
                pg8::EpiSwiGLU E{HB, DFF, RS};
                pg8::gemm_phase<pg8::EpiSwiGLU, pg8::StaticOrder, true, true>(lds, g, S, E, tid);
            } else if (s == 1 || s == 8) {
                pg8::Gemm g{HB, (const bf16_t*)(wl + (s == 1 ? WL_D1 : WL_D2)), MTOK, DM, DFF};
                pg8::StaticOrder S; S.init(MTOK, DM, G, bid, ph & 1);
                pg8::EpiStore E{FB, DM, 0, nullptr};
                pg8::gemm_phase<pg8::EpiStore, pg8::StaticOrder, true, true, true>(lds, g, S, E, tid);
            } else if (s == 3 || s == 5) {
                const bf16_t* A = (s == 3) ? XB : YB;
                const size_t wo = (s == 3) ? WL_IN : WL_OUT;
                const int N = (s == 3) ? NIN : DM, K = DM;
                bf16_t* O = (s == 3) ? PROJ : FB;
                pg8::Gemm g{A, (const bf16_t*)(wl + wo), MTOK, N, K};
                pg8::StaticOrder S; S.init(MTOK, N, G, bid, ph & 1);
                pg8::EpiStore E{O, N, (s == 3) ? 1 : 0, (s == 3) ? RS : nullptr};
                pg8::gemm_phase<pg8::EpiStore, pg8::StaticOrder, true, true>(lds, g, S, E, tid);
            } else if (s == 4) {
                const float lambda_init = 0.8f - 0.6f * __expf(-0.3f * (float)l);
                float lam;
                { const float* q1 = args.in[9] + 32 * l; const float* k1 = args.in[10] + 32 * l; const float* q2 = args.in[11] + 32 * l; const float* k2 = args.in[12] + 32 * l;
                  float v = lane < 32 ? q1[lane] * k1[lane] : q2[lane - 32] * k2[lane - 32];
#pragma unroll
                  for (int o = 1; o < 32; o <<= 1) v += shx(v, lane, o);
                  const float s1 = __int_as_float(__builtin_amdgcn_readlane(__float_as_int(v), 0)), s2 = __int_as_float(__builtin_amdgcn_readlane(__float_as_int(v), 32)); lam = __expf(s1) - __expf(s2) + lambda_init; }
                LAS int* uw = (LAS int*)(lds + att::OFF_UNIT);
                unsigned* qctr = ctl + 64 * 4 * (l + DEPTH * rep);
#define NEXT_UNIT(q, n) if (tid == 0) *uw = (int)atomicAdd(qctr + 64 * (q), 1u); __syncthreads(); const int u = *uw; __syncthreads(); if (u >= (n)) break;
#ifndef NO_B
                for (;;) { NEXT_UNIT(0, 1024)
                    const int qb = 7 - u / 128, w_ = u % 128, b = 31 - w_ / 4, hh = w_ % 4;
                    att::attn_unit<1>(lds, PROJ, YB, b, qb, 1152 + 64 * hh, 1408 + 64 * hh, 1664 + 64 * hh, 384 + 64 * hh, nullptr,
                                      __builtin_amdgcn_exp2f(-2.0f * (float)(hh + 1)) * LOG2E, lam, args.in[13] + 64 * l, 1.0f - lambda_init, tid); }
#endif
#ifndef NO_C
                for (;;) { NEXT_UNIT(1, 1536)
                    const int qb = 7 - u / 192, w_ = u % 192, b = 31 - w_ / 6, hc = w_ % 6;
                    att::attn_unit<2>(lds, PROJ, YB, b, qb, 1920 + 64 * hc, 2304 + 64 * hc, 2688 + 64 * hc, 640 + 64 * hc, nullptr, 0.f, 0.f, nullptr, 0.f, tid); }
#endif
#ifndef NO_A
                for (;;) { NEXT_UNIT(2, 1536)
                    const int b = 31 - u / 48, r_ = u % 48, ha = r_ / 8, qb = r_ % 8;
                    att::attn_unit<0>(lds, PROJ, YB, b, qb, 64 * ha, 384 + 64 * ha, 768 + 64 * ha, 64 * ha, args.in[8] + (size_t)(l * 6 + ha) * 257, 0.f, 0.f, nullptr, 0.f, tid); }
#endif
#undef NEXT_UNIT
            } else {
                const float* gpost = (s == 2) ? args.in[5] + DM * l : (s == 6) ? args.in[15] + DM * l : args.in[20] + DM * l;
                const float wgt = (s == 6) ? 1.0f : 0.5f;
                if (l == 0 && s == 2) norm_rows<true, false, true>(args.in[0], FB, wgt, gpost, XB, RS, gw, ngw, lane, ph & 1);
                else if (l == DEPTH - 1 && s == 9) norm_rows<true, true, false>(XB, FB, wgt, gpost, args.out, nullptr, gw, ngw, lane, ph & 1);
                else norm_rows<true, true, true>(XB, FB, wgt, gpost, XB, RS, gw, ngw, lane, ph & 1);
            }
        }
        if (phx + 1 < hi_x) {
            volatile LAS unsigned* bst = (volatile LAS unsigned*)(lds + MISC_OFF) + 8;
            if (phx == lo) {
                cg::this_grid().sync();
                (void)xcd_barrier_post(ctl + CW_BAR, bst);
            } else { XcdBarrier xb; xb.bar = ctl + CW_BAR; xb.x = xb_xcc_id(); xb.st = bst; xcd_barrier(xb); }
        }
#undef args
    }
}

extern "C" void kernel_launch(void* const* d_in, const int* in_sizes, int n_in, void* d_out, int out_size, void* d_ws, size_t ws_size, hipStream_t stream) {
    static int grid = 0;
    if (grid == 0) {
        if (n_in != 21 || out_size != MTOK * DM || ws_size < WS_END) { fprintf(stderr, "kernel_launch: unexpected shapes (n_in %d, out %d, ws %zu)\n", n_in, out_size, ws_size); grid = -1; return; }
        int dev = 0, cus = 0, per_cu = 0;
        hipGetDevice(&dev); hipDeviceGetAttribute(&cus, hipDeviceAttributeMultiprocessorCount, dev);
        if (hipFuncSetAttribute((const void*)mega_fwd, hipFuncAttributeMaxDynamicSharedMemorySize, LDS_BYTES) != hipSuccess) { fprintf(stderr, "kernel_launch: hipFuncSetAttribute failed\n"); }
        if (hipOccupancyMaxActiveBlocksPerMultiprocessor(&per_cu, (const void*)mega_fwd, NTHREADS, LDS_BYTES) != hipSuccess || per_cu < 1) { fprintf(stderr, "kernel_launch: occupancy query gave %d\n", per_cu); per_cu = 1; }
        (void)hipGetLastError();
        grid = cus * 1;
        fprintf(stderr, "kernel_launch: grid %d (per_cu %d)\n", grid, per_cu);
    }
    if (grid < 0) return;
    Args a{};
    for (int i = 0; i < 21; ++i) a.in[i] = (const float*)d_in[i];
    a.out = (float*)d_out; a.ws = (unsigned char*)d_ws;
#if MULTI_LAUNCH
    for (int ph = 0; ph < NPH; ++ph) { a.ph_lo = ph; a.ph_hi = ph + 1; hipLaunchKernelGGL(mega_fwd, dim3(grid), dim3(NTHREADS), LDS_BYTES, stream, a); }
#else
    a.ph_lo = 0; a.ph_hi = NPH;
    void* kargs[] = {&a};
    hipError_t e = hipLaunchCooperativeKernel((const void*)mega_fwd, dim3(grid), dim3(NTHREADS), kargs, LDS_BYTES, stream);
    if (e != hipSuccess) fprintf(stderr, "kernel_launch: cooperative launch failed: %s (grid %d)\n", hipGetErrorString(e), grid);
#endif
}
```
